# Optimizing an MI355X kernel written in HIP

```python
import jax
import jax.numpy as jnp
from jax import lax
import numpy as np

D_MODEL = 1024
BATCH = 2
SEQ = 8192
DEPTH = 2

HEAD_DIM = 64
H_NSA = 4
H_DIL = 6
H_SB = 6
DIL_PAIRS = ((128, 1), (512, 4), (2048, 16))
N_DIL_GROUPS = len(DIL_PAIRS)
H_PER_DIL = H_DIL // N_DIL_GROUPS
CMP_LEN = 32
CMP_STRIDE = 16
CMP_HIDDEN = 128
SEL_BLOCK = 64
SEL_TOPK = 16
WIN_NSA = 512
Q_BLOCK = 128
D_FF = 4 * D_MODEL
N_SOFTMAX_HEADS = H_NSA + H_DIL
RMS_EPS = 1e-6
NEG_INF = -1e30
FORCE_BONUS = 1e4

NSA_Q_W = H_NSA * HEAD_DIM
NSA_KV_W = 6 * HEAD_DIM
NSA_GATE_W = 3 * H_NSA
DIL_W = 3 * H_DIL * HEAD_DIM
SB_W = 3 * H_SB * HEAD_DIM
D_PROJ = NSA_Q_W + NSA_KV_W + NSA_GATE_W + DIL_W + SB_W
PROJ_SPLITS = (NSA_Q_W, NSA_Q_W + NSA_KV_W, NSA_Q_W + NSA_KV_W + NSA_GATE_W,
               NSA_Q_W + NSA_KV_W + NSA_GATE_W + DIL_W)
D_CAT = (H_NSA + H_PER_DIL + H_SB) * HEAD_DIM

kernel_name = 'hybrid_nsa_dilated_stickbreak_block'


def rms_norm(x, g):
    xf = x.astype(jnp.float32)
    y = xf * lax.rsqrt(jnp.mean(xf * xf, axis=-1, keepdims=True) + RMS_EPS)
    return (y * g.astype(jnp.float32)).astype(x.dtype)


def alibi_slopes():
    i = jnp.arange(1, N_SOFTMAX_HEADS + 1, dtype=jnp.float32)
    return jnp.exp2(-8.0 * i / N_SOFTMAX_HEADS)


def masked_softmax(s, mask):
    s = jnp.where(mask, s, NEG_INF)
    m = jnp.max(s, axis=-1, keepdims=True)
    p = jnp.where(mask, jnp.exp(s - m), 0.0)
    l = jnp.maximum(jnp.sum(p, axis=-1, keepdims=True), 1e-30)
    return p / l, (m + jnp.log(l))[..., 0]


def unblock(y):
    y = jnp.moveaxis(y, 0, 1)
    return y.reshape((y.shape[0], y.shape[1] * y.shape[2]) + y.shape[3:])


def nsa_mixer(q, kv, gate_logits, qk_gain, cmp_pe, cmp_w1, cmp_w2, slopes):
    B, S = q.shape[0], q.shape[1]
    dt = q.dtype
    scale = HEAD_DIM ** -0.5
    q = rms_norm(q, qk_gain[0])
    k_sel = rms_norm(kv[:, :, 2], qk_gain[2])
    v_sel = kv[:, :, 3]
    k_win = rms_norm(kv[:, :, 4], qk_gain[3])
    v_win = kv[:, :, 5]
    n_cmp = (S - CMP_LEN) // CMP_STRIDE + 1
    cmp_start = CMP_STRIDE * jnp.arange(n_cmp)
    cmp_end = cmp_start + CMP_LEN - 1
    cmp_idx = cmp_start[:, None] + jnp.arange(CMP_LEN)[None]
    raw = kv[:, :, 0:2].transpose(0, 2, 1, 3)[:, :, cmp_idx]
    raw = (raw + cmp_pe[None, :, None]).reshape(B, 2, n_cmp, CMP_LEN * HEAD_DIM)
    hid = jax.nn.gelu(jnp.einsum('bcnf,cfh->bcnh', raw, cmp_w1))
    kv_c = jnp.einsum('bcnh,chd->bcnd', hid, cmp_w2)
    k_c = rms_norm(kv_c[:, 0], qk_gain[1])
    v_c = kv_c[:, 1]
    n_sel = S // SEL_BLOCK
    sel_start = SEL_BLOCK * jnp.arange(n_sel)
    overlap = ((cmp_start[:, None] <= sel_start[None] + SEL_BLOCK - 1)
               & (cmp_end[:, None] >= sel_start[None])).astype(jnp.float32)
    k_top = min(SEL_TOPK, n_sel)
    sel_offsets = jnp.arange(SEL_BLOCK)
    sel_ids = jnp.arange(n_sel)
    k_win_p = jnp.pad(k_win, ((0, 0), (WIN_NSA, 0), (0, 0)))
    v_win_p = jnp.pad(v_win, ((0, 0), (WIN_NSA, 0), (0, 0)))
    win_offsets = jnp.arange(WIN_NSA + Q_BLOCK)
    gates = jax.nn.sigmoid(gate_logits.astype(jnp.float32)).astype(dt)
    gather_rows = jax.vmap(lambda a, i: a[i])

    def block(n):
        t0 = n * Q_BLOCK
        t = t0 + jnp.arange(Q_BLOCK)
        qb = lax.dynamic_slice_in_dim(q, t0, Q_BLOCK, axis=1)
        d_c = (t[:, None] - cmp_end[None]).astype(jnp.float32)
        s = jnp.einsum('bqhd,bnd->bhqn', qb, k_c).astype(jnp.float32) * scale - slopes[:, None, None] * d_c
        p_c, _ = masked_softmax(s, d_c >= 0)
        o_c = jnp.einsum('bhqn,bnd->bqhd', p_c.astype(dt), v_c)
        imp = jnp.einsum('bhqn,nj->bqj', p_c, overlap)
        cur = t // SEL_BLOCK
        forced = (sel_ids[None] == 0) | (sel_ids[None] == cur[:, None]) | (sel_ids[None] == cur[:, None] - 1)
        imp = jnp.where(forced, imp + FORCE_BONUS, imp)
        imp = jnp.where(sel_start[None] <= t[:, None], imp, NEG_INF)
        _, top = lax.top_k(imp, k_top)
        tok = (top[..., None] * SEL_BLOCK + sel_offsets).reshape(B, Q_BLOCK, k_top * SEL_BLOCK)
        k_g = gather_rows(k_sel, tok)
        v_g = gather_rows(v_sel, tok)
        d_s = (t[None, :, None] - tok).astype(jnp.float32)
        s = jnp.einsum('bqhd,bqkd->bhqk', qb, k_g).astype(jnp.float32) * scale - slopes[None, :, None, None] * d_s[:, None]
        p_s, _ = masked_softmax(s, (d_s >= 0)[:, None])
        o_s = jnp.einsum('bhqk,bqkd->bqhd', p_s.astype(dt), v_g)
        k_w = lax.dynamic_slice_in_dim(k_win_p, t0, WIN_NSA + Q_BLOCK, axis=1)
        v_w = lax.dynamic_slice_in_dim(v_win_p, t0, WIN_NSA + Q_BLOCK, axis=1)
        kpos = t0 - WIN_NSA + win_offsets
        d_w = (t[:, None] - kpos[None]).astype(jnp.float32)
        mask_w = (d_w >= 0) & (d_w < WIN_NSA) & (kpos[None] >= 0)
        s = jnp.einsum('bqhd,bkd->bhqk', qb, k_w).astype(jnp.float32) * scale - slopes[:, None, None] * d_w
        p_w, _ = masked_softmax(s, mask_w)
        o_w = jnp.einsum('bhqk,bkd->bqhd', p_w.astype(dt), v_w)
        g = lax.dynamic_slice_in_dim(gates, t0, Q_BLOCK, axis=1)
        return g[..., 0:1] * o_c + g[..., 1:2] * o_s + g[..., 2:3] * o_w

    return unblock(lax.map(block, jnp.arange(S // Q_BLOCK)))


def dilated_mixer(qkv, qk_gain, slopes):
    S = qkv.shape[1]
    dt = qkv.dtype
    scale = HEAD_DIM ** -0.5
    q = rms_norm(qkv[:, :, 0], qk_gain[0])
    k = rms_norm(qkv[:, :, 1], qk_gain[1])
    v = qkv[:, :, 2]
    k_groups = [k[:, :, g] for g in range(N_DIL_GROUPS)]
    v_groups = [v[:, :, g] for g in range(N_DIL_GROUPS)]
    slopes_g = slopes.reshape(N_DIL_GROUPS, H_PER_DIL)

    def block(n):
        t0 = n * Q_BLOCK
        t = t0 + jnp.arange(Q_BLOCK)
        qb = lax.dynamic_slice_in_dim(q, t0, Q_BLOCK, axis=1)
        outs, lses = [], []
        for g, (w, r) in enumerate(DIL_PAIRS):
            dist = r * jnp.arange(w // r + 1)
            kidx = t[:, None] - dist[None]
            valid = kidx >= 0
            kidx = jnp.maximum(kidx, 0)
            k_g = k_groups[g][:, kidx]
            v_g = v_groups[g][:, kidx]
            s = (jnp.einsum('bqhd,bqjhd->bhqj', qb[:, :, g], k_g).astype(jnp.float32) * scale
                 - slopes_g[g][:, None, None] * dist.astype(jnp.float32))
            p, lse = masked_softmax(s, valid)
            outs.append(jnp.einsum('bhqj,bqjhd->bqhd', p.astype(dt), v_g))
            lses.append(lse)
        alpha = jax.nn.softmax(jnp.stack(lses), axis=0)
        alpha = jnp.transpose(alpha, (0, 1, 3, 2))[..., None].astype(dt)
        return jnp.sum(alpha * jnp.stack(outs), axis=0)

    return unblock(lax.map(block, jnp.arange(S // Q_BLOCK)))


def stick_breaking_mixer(qkv):
    S = qkv.shape[1]
    dt = qkv.dtype
    scale = HEAD_DIM ** -0.5
    q, k, v = qkv[:, :, 0], qkv[:, :, 1], qkv[:, :, 2]
    kpos = jnp.arange(S)

    def block(n):
        t0 = n * Q_BLOCK
        t = t0 + jnp.arange(Q_BLOCK)
        qb = lax.dynamic_slice_in_dim(q, t0, Q_BLOCK, axis=1)
        z = jnp.einsum('bqhd,bshd->bhqs', qb, k).astype(jnp.float32) * scale
        causal = kpos[None] < t[:, None]
        log_beta = jax.nn.log_sigmoid(z)
        log_fail = jnp.where(causal, jax.nn.log_sigmoid(-z), 0.0)
        after = lax.cumsum(log_fail, axis=3, reverse=True) - log_fail
        a = jnp.where(causal, jnp.exp(log_beta + after), 0.0)
        return jnp.einsum('bhqs,bshd->bqhd', a.astype(dt), v)

    return unblock(lax.map(block, jnp.arange(S // Q_BLOCK)))


def setup_inputs(seed: int = 0) -> dict:
    key = jax.random.key(seed)
    ks = jax.random.split(key, 12)
    f32 = jnp.float32

    def nrm(k, shape, fan_in):
        return jax.random.normal(k, shape, f32) * (fan_in ** -0.5)

    def gain(k, shape):
        return 1.0 + 0.02 * jax.random.normal(k, shape, f32)

    return {
        'x': jax.random.normal(ks[0], (BATCH, SEQ, D_MODEL), f32),
        'norm_mix': gain(ks[1], (DEPTH, D_MODEL)),
        'norm_mlp': gain(ks[2], (DEPTH, D_MODEL)),
        'w_in': nrm(ks[3], (DEPTH, D_MODEL, D_PROJ), D_MODEL),
        'qk_gain_nsa': gain(ks[4], (DEPTH, 4, HEAD_DIM)),
        'qk_gain_dil': gain(ks[5], (DEPTH, 2, HEAD_DIM)),
        'cmp_pe': 0.1 * jax.random.normal(ks[6], (DEPTH, 2, CMP_LEN, HEAD_DIM), f32),
        'cmp_w1': nrm(ks[7], (DEPTH, 2, CMP_LEN * HEAD_DIM, CMP_HIDDEN), CMP_LEN * HEAD_DIM),
        'cmp_w2': nrm(ks[8], (DEPTH, 2, CMP_HIDDEN, HEAD_DIM), CMP_HIDDEN),
        'w_out': nrm(ks[9], (DEPTH, D_CAT, D_MODEL), D_CAT),
        'w_up': nrm(ks[10], (DEPTH, D_MODEL, D_FF), D_MODEL),
        'w_down': nrm(ks[11], (DEPTH, D_FF, D_MODEL), D_FF),
    }


def reference(x, norm_mix, norm_mlp, w_in, qk_gain_nsa, qk_gain_dil, cmp_pe, cmp_w1, cmp_w2,
              w_out, w_up, w_down):
    B, S, _ = x.shape
    slopes = alibi_slopes()
    slopes_dil = slopes[:H_DIL]
    slopes_nsa = slopes[H_DIL:]
    for l in range(DEPTH):
        h = rms_norm(x, norm_mix[l])
        proj = h @ w_in[l]
        a_q, a_kv, a_g, b_qkv, c_qkv = jnp.split(proj, PROJ_SPLITS, axis=-1)
        o_a = nsa_mixer(a_q.reshape(B, S, H_NSA, HEAD_DIM), a_kv.reshape(B, S, 6, HEAD_DIM),
                        a_g.reshape(B, S, H_NSA, 3), qk_gain_nsa[l], cmp_pe[l], cmp_w1[l],
                        cmp_w2[l], slopes_nsa)
        o_b = dilated_mixer(b_qkv.reshape(B, S, 3, N_DIL_GROUPS, H_PER_DIL, HEAD_DIM),
                            qk_gain_dil[l], slopes_dil)
        o_c = stick_breaking_mixer(c_qkv.reshape(B, S, 3, H_SB, HEAD_DIM))
        cat = jnp.concatenate([o_a.reshape(B, S, -1), o_b.reshape(B, S, -1),
                               o_c.reshape(B, S, -1)], axis=-1)
        x = x + cat @ w_out[l]
        h = rms_norm(x, norm_mlp[l])
        x = x + jnp.square(jax.nn.relu(h @ w_up[l])) @ w_down[l]
    return x
```

```cpp
#include <hip/hip_runtime.h>
#include <hip/hip_cooperative_groups.h>
#include <stdint.h>
#include <stdio.h>
namespace cg = cooperative_groups;
#ifndef REP_P0
#define REP_P0 1
#endif
#ifndef REP_SYNC
#define REP_SYNC 1
#endif
#ifndef REP_CMP
#define REP_CMP 1
#endif
#ifndef REP_SB
#define REP_SB 1
#endif
#ifndef REP_DIL
#define REP_DIL 1
#endif
#ifndef REP_NSA
#define REP_NSA 1
#endif
#ifndef REP_SEL
#define REP_SEL 1
#endif
#ifndef REP_WIN
#define REP_WIN 1
#endif
#ifndef REP_CMPA
#define REP_CMPA 1
#endif
#ifndef REP_EPI
#define REP_EPI 1
#endif
#ifndef REP_P1
#define REP_P1 1
#endif
#ifndef REP_P2A
#define REP_P2A 1
#endif
#ifndef REP_P2B
#define REP_P2B 1
#endif
#ifndef REP_P3B
#define REP_P3B 1
#endif

typedef unsigned short bf16;
typedef short s16x8 __attribute__((ext_vector_type(8)));
typedef short s16x4 __attribute__((ext_vector_type(4)));
typedef float f32x4 __attribute__((ext_vector_type(4)));
typedef float f32x16 __attribute__((ext_vector_type(16)));
typedef unsigned u32x4 __attribute__((ext_vector_type(4)));

#define DI __device__ __forceinline__
#define MFMA16(a, b, c) __builtin_amdgcn_mfma_f32_16x16x32_bf16((a), (b), (c), 0, 0, 0)
#define MFMA32(a, b, c) __builtin_amdgcn_mfma_f32_32x32x16_bf16((a), (b), (c), 0, 0, 0)

constexpr int DM = 1024, SEQ = 8192, NB = 2, NT = NB * SEQ, NP = 3072, DCAT = 768, DFF = 4096;
constexpr float LOG2E = 1.4426950408889634f;
constexpr float EPS = 1e-6f;
constexpr float NEGB = -1e30f;

constexpr size_t OFF_WIN = 0;
constexpr size_t OFF_WOUT = 12582912;
constexpr size_t OFF_WUP = 15728640;
constexpr size_t OFF_WDN = 32505856;
constexpr size_t OFF_W1T = 49283072;
constexpr size_t OFF_W2T = 51380224;
constexpr size_t OFF_XB = 51445760;
constexpr size_t OFF_SSQ = 85000192;
constexpr size_t OFF_KC = 85524480;
constexpr size_t OFF_VC = 85655552;
constexpr size_t OFF_PROJ = 85786624;
constexpr size_t OFF_DILO = 186449920;
constexpr size_t OFF_DILL = 211615744;
constexpr size_t OFF_CAT = 212008960;
constexpr size_t OFF_U = OFF_PROJ;
constexpr size_t OFF_BAR = 237174784;
constexpr size_t OFF_QCNT = OFF_BAR + 14336;
constexpr size_t WS_NEED = 237174784 + 16384;

constexpr int NTHR = 512;
constexpr int LDS_BYTES = 131072 + 8192;
constexpr int L_SSL = 131072;
constexpr int L_XB = 131072 + 4096;
constexpr int L_QS = 131072 + 4096 + 64;
constexpr int L_VS = 9216, L_KVB = 18432, L_IMP = 36864, L_IMPE = 70656, L_SELM = 104448, L_LIST = 105472, L_FLAG = 106000;
constexpr int KROW = 144;
constexpr int IMPW = 132;

struct Params {
  const float *x, *norm_mix, *norm_mlp, *w_in, *g_nsa, *g_dil, *pe, *w1, *w2, *w_out, *w_up, *w_down;
  float* out;
  unsigned char* ws;
};

DI unsigned short f2bf(float x) { unsigned u = __float_as_uint(x); u += 0x7fffu + ((u >> 16) & 1u); return (unsigned short)(u >> 16); }
DI float bf2f(unsigned short b) { return __uint_as_float(((unsigned)b) << 16); }
typedef __bf16 bf16x2v __attribute__((ext_vector_type(2)));
DI unsigned pack2(float a, float b) { bf16x2v v; v[0] = (__bf16)a; v[1] = (__bf16)b; return __builtin_bit_cast(unsigned, v); }
DI int tid_opaque() { int t = threadIdx.x; asm volatile("" : "+v"(t)); return t; }
DI size_t blk(int nrows, int row, int col) { return ((size_t)(col >> 6) * nrows + row) * 64 + (col & 63); }
DI int crow(int i, int half) { return (i & 3) + 8 * (i >> 2) + 4 * half; }

struct TrDesc { const float* src; int srcN, srcCol0, nvalid, k0; bf16* dst; int dstK, n0; const float* gain; int perm, dstN; };
struct TrRegs { f32x4 v[2]; float g[2]; };

DI void tr_load(const TrDesc& d, int tid, TrRegs& r) {
#pragma unroll
  for (int i = 0; i < 2; ++i) {
    const int idx = tid + i * 512, kk = idx >> 4, nn = (idx & 15) * 4;
    r.v[i] = f32x4{0.f, 0.f, 0.f, 0.f}; r.g[i] = 1.f;
    if (nn < d.nvalid) {
      r.v[i] = *(const f32x4*)(d.src + (size_t)(d.k0 + kk) * d.srcN + d.srcCol0 + nn);
      if (d.gain) r.g[i] = d.gain[d.k0 + kk];
    }
  }
}
DI void tr_finish(const TrDesc& d, int tid, const TrRegs& r, float* lds) {
  __syncthreads();
#pragma unroll
  for (int i = 0; i < 2; ++i) {
    const int idx = tid + i * 512, kk = idx >> 4, nn = (idx & 15) * 4;
    const float g = r.g[i];
    lds[kk * 65 + nn] = r.v[i][0] * g; lds[kk * 65 + nn + 1] = r.v[i][1] * g; lds[kk * 65 + nn + 2] = r.v[i][2] * g; lds[kk * 65 + nn + 3] = r.v[i][3] * g;
  }
  __syncthreads();
  {
    int n = tid >> 3, kc = (tid & 7) * 8;
    u32x4 o;
    o[0] = pack2(lds[(kc + 0) * 65 + n], lds[(kc + 1) * 65 + n]);
    o[1] = pack2(lds[(kc + 2) * 65 + n], lds[(kc + 3) * 65 + n]);
    o[2] = pack2(lds[(kc + 4) * 65 + n], lds[(kc + 5) * 65 + n]);
    o[3] = pack2(lds[(kc + 6) * 65 + n], lds[(kc + 7) * 65 + n]);
    const int xg = n & 31, xp = d.dstN ? (((xg >> 2) & 1) * 16 + (xg >> 3) * 4 + (xg & 3)) : xg;
    int drow = d.n0 + (n & 32) + xp;
    if (d.perm) {
      int tb = d.n0 & ~255, wc = (d.n0 >> 6) & 3;
      drow = tb + (n >> 5) * 128 + wc * 32 + xp;
    }
    if (d.dstN) *(u32x4*)(d.dst + ((size_t)(d.k0 >> 6) * d.dstN + drow) * 64 + kc) = o;
    else *(u32x4*)(d.dst + (size_t)drow * d.dstK + d.k0 + kc) = o;
  }
}

DI TrDesc wconv_desc(const Params& p, int l, int q) {
  TrDesc d;
  if (q < 768) {
    int nc = q / 16, kt = q % 16, n0 = nc * 64;
    int src0, nvalid;
    if (n0 < 640) { src0 = n0; nvalid = 64; }
    else if (n0 < 2944) { src0 = n0 + 12; nvalid = 64; }
    else if (n0 == 2944) { src0 = 640; nvalid = 12; }
    else { src0 = 0; nvalid = 0; }
    d = TrDesc{p.w_in + (size_t)l * 1024 * 2956, 2956, src0, nvalid, kt * 64, (bf16*)(p.ws + OFF_WIN) + (size_t)l * 3072 * 1024, 1024, n0, p.norm_mix + l * 1024, 1, 3072};
  } else if (q < 960) {
    int qq = q - 768, nc = qq / 12, kt = qq % 12;
    d = TrDesc{p.w_out + (size_t)l * 768 * 1024, 1024, nc * 64, 64, kt * 64, (bf16*)(p.ws + OFF_WOUT) + (size_t)l * 1024 * 768, 768, nc * 64, nullptr, 0, 1024};
  } else if (q < 1984) {
    int qq = q - 960, nc = qq / 16, kt = qq % 16;
    d = TrDesc{p.w_up + (size_t)l * 1024 * 4096, 4096, nc * 64, 64, kt * 64, (bf16*)(p.ws + OFF_WUP) + (size_t)l * 4096 * 1024, 1024, nc * 64, p.norm_mlp + l * 1024, 0, 4096};
  } else if (q < 3008) {
    int qq = q - 1984, nc = qq / 64, kt = qq % 64;
    d = TrDesc{p.w_down + (size_t)l * 4096 * 1024, 1024, nc * 64, 64, kt * 64, (bf16*)(p.ws + OFF_WDN) + (size_t)l * 1024 * 4096, 4096, nc * 64, nullptr, 0, 1024};
  } else if (q < 3136) {
    int qq = q - 3008, c = qq / 64, r2 = qq % 64, nc = r2 / 32, kt = r2 % 32;
    d = TrDesc{p.w1 + ((size_t)l * 2 + c) * 2048 * 128, 128, nc * 64, 64, kt * 64, (bf16*)(p.ws + OFF_W1T) + ((size_t)l * 2 + c) * 128 * 2048, 2048, nc * 64, nullptr, 0, 0};
  } else {
    int qq = q - 3136, c = qq / 2, kt = qq % 2;
    d = TrDesc{p.w2 + ((size_t)l * 2 + c) * 128 * 64, 64, 0, 64, kt * 64, (bf16*)(p.ws + OFF_W2T) + ((size_t)l * 2 + c) * 64 * 128, 128, 0, nullptr, 0, 0};
  }
  return d;
}
DI void tr_direct(const TrDesc& d, int t) {
  const int kgrp = t >> 4, nn = (t & 15) * 4, kc = kgrp * 8;
  f32x4 v[8];
  f32x4 g0 = f32x4{1.f, 1.f, 1.f, 1.f}, g1 = g0;
#pragma unroll
  for (int j = 0; j < 8; ++j) v[j] = f32x4{0.f, 0.f, 0.f, 0.f};
  if (nn < d.nvalid) {
#pragma unroll
    for (int j = 0; j < 8; ++j) v[j] = *(const f32x4*)(d.src + (size_t)(d.k0 + kc + j) * d.srcN + d.srcCol0 + nn);
    if (d.gain) { g0 = *(const f32x4*)(d.gain + d.k0 + kc); g1 = *(const f32x4*)(d.gain + d.k0 + kc + 4); }
  }
  __builtin_amdgcn_sched_barrier(0);
#pragma unroll
  for (int c = 0; c < 4; ++c) {
    u32x4 o;
    o[0] = pack2(v[0][c] * g0[0], v[1][c] * g0[1]); o[1] = pack2(v[2][c] * g0[2], v[3][c] * g0[3]);
    o[2] = pack2(v[4][c] * g1[0], v[5][c] * g1[1]); o[3] = pack2(v[6][c] * g1[2], v[7][c] * g1[3]);
    const int n = nn + c;
    const int xg = n & 31, xp = d.dstN ? (((xg >> 2) & 1) * 16 + (xg >> 3) * 4 + (xg & 3)) : xg;
    int drow = d.n0 + (n & 32) + xp;
    if (d.perm) {
      int tb = d.n0 & ~255, wc = (d.n0 >> 6) & 3;
      drow = tb + (n >> 5) * 128 + wc * 32 + xp;
    }
    if (d.dstN) *(u32x4*)(d.dst + ((size_t)(d.k0 >> 6) * d.dstN + drow) * 64 + kc) = o;
    else *(u32x4*)(d.dst + (size_t)drow * d.dstK + d.k0 + kc) = o;
  }
}
DI void wconv_run(const Params& p, int l, int first, int last, int stride, float* lds) {
  const int tid = tid_opaque();
  const int tq = tid >> 7, t = tid & 127;
  for (int q = first + tq * stride; q < last; q += 4 * stride) {
    int qv = q; asm volatile("" : "+v"(qv));
    const TrDesc d = wconv_desc(p, l, qv);
    tr_direct(d, t);
  }
}
DI void wconv_run_lds(const Params& p, int l, int first, int last, int stride, float* lds) {
  const int tid = tid_opaque();
  if (first >= last) return;
  TrDesc d = wconv_desc(p, l, first); TrRegs r;
  tr_load(d, tid, r);
  for (int q = first; q < last; q += stride) {
    TrDesc dn = d; TrRegs rn = r;
    const bool more = (q + stride < last);
    if (more) { dn = wconv_desc(p, l, q + stride); tr_load(dn, tid, rn); }
    tr_finish(d, tid, r, lds);
    d = dn; r = rn;
  }
}
constexpr int WCONV_TILES = 768 + 192 + 1024 + 1024 + 128 + 4;
constexpr int WCONV_CHUNK = 16;
constexpr int WCONV_L0Q = 3008 - 768;
constexpr int WCONV_QTILES = WCONV_L0Q + WCONV_TILES;
constexpr int WCONV_NCHUNK = (WCONV_QTILES + WCONV_CHUNK - 1) / WCONV_CHUNK;

__device__ void phase0(const Params& p, char* smem) {
  float* lds = (float*)smem;
  const int NTR = WCONV_TILES;
  const int NX = NT / 8;
  wconv_run_lds(p, 0, blockIdx.x, 768, gridDim.x, lds);
  wconv_run_lds(p, 0, 3008 + blockIdx.x, WCONV_TILES, gridDim.x, lds);
  for (int it = blockIdx.x; it < NX; it += gridDim.x) {
    const int tid0 = tid_opaque();
    int row = it * 8 + (tid0 >> 6), lane = tid0 & 63;
    const float* xr = p.x + (size_t)row * DM;
    bf16* xb = (bf16*)(p.ws + OFF_XB);
    f32x4 xv[4];
#pragma unroll
    for (int i = 0; i < 2; ++i) { xv[2 * i] = *(const f32x4*)(xr + i * 512 + lane * 8); xv[2 * i + 1] = *(const f32x4*)(xr + i * 512 + lane * 8 + 4); }
    __builtin_amdgcn_sched_barrier(0);
    float ss = 0.f;
#pragma unroll
    for (int i = 0; i < 2; ++i) {
      const f32x4 v = xv[2 * i], w4 = xv[2 * i + 1];
      ss += (v[0] * v[0] + v[1] * v[1] + v[2] * v[2] + v[3] * v[3]) + (w4[0] * w4[0] + w4[1] * w4[1] + w4[2] * w4[2] + w4[3] * w4[3]);
      u32x4 o;
      o[0] = pack2(v[0], v[1]); o[1] = pack2(v[2], v[3]); o[2] = pack2(w4[0], w4[1]); o[3] = pack2(w4[2], w4[3]);
      *(u32x4*)(xb + blk(NT, row, i * 512 + lane * 8)) = o;
    }
    for (int o = 32; o > 0; o >>= 1) ss += __shfl_xor(ss, o);
    float* sq = (float*)(p.ws + OFF_SSQ) + (size_t)row * 8;
    if (lane < 8) sq[lane] = (lane == 0) ? ss : 0.f;
  }
}

DI int lds_byte(int r, int c) {
  int st = (r >> 4) * 2 + (c >> 5), rr = r & 15, cc = c & 31, ob = rr * 64 + cc * 2;
  return st * 1024 + (ob ^ (((ob >> 9) & 1) << 5));
}
DI void stage_rc(int b, int& R, int& C) {
  int st = b / 1024, sb = b % 1024, swz = sb ^ (((sb >> 9) & 1) << 5);
  R = (st >> 1) * 16 + swz / 64; C = (st & 1) * 32 + (swz % 64) / 2;
}
enum { EPI_PROJ = 0, EPI_RES = 1, EPI_UP = 2 };

struct EpiArgs {
  int layer;
  const float* g_nsa;
  const float* g_dil;
  const float* ssq;
  bf16* outb;
  const float* resid;
  float* outf;
  float* ssq_out;
};

#define LAS __attribute__((address_space(3)))
#define WAIT_V(n) asm volatile("s_waitcnt vmcnt(" #n ")" ::: "memory")
#define WAIT_L(n) asm volatile("s_waitcnt lgkmcnt(" #n ")" ::: "memory")
#define BAR __builtin_amdgcn_s_barrier()
#define SCHED __builtin_amdgcn_sched_barrier(0)

DI uint2 pack4(float a, float b, float c, float d) { return make_uint2(pack2(a, b), pack2(c, d)); }

template <int EPI>
__device__ void gemm8(const bf16* A, const bf16* Bt, const int K, const int ntN, const int ntTot, const EpiArgs ea, char* smem) {
  const int tid = tid_opaque(), wid = tid >> 6, lane = tid & 63, wr = wid >> 2, wc = wid & 3, fr = lane & 15, fq = lane >> 4;
  int R0, C0;
  stage_rc(tid * 16, R0, C0);
  const unsigned goffb = (unsigned)(R0 * 64 + C0) * 2u;
  const size_t ssA = (size_t)NT * 128, ssB = (size_t)ntN * 256 * 128;
  const int ldst = __builtin_amdgcn_readfirstlane(tid * 16);
  const int a_rd = lds_byte(wr * 64 + fr, fq * 8), b_rd = 65536 + lds_byte(wc * 32 + fr, fq * 8);
  const int nt = K / 64;
  const int G = gridDim.x;
  const int vb = (blockIdx.x & 7) * (G >> 3) + (blockIdx.x >> 3);
  float* ssl = (float*)(smem + L_SSL);
#define SA(b, h) (smem + ((b) * 2 + (h)) * 16384)
#define SB(b, h) (smem + (4 + (b) * 2 + (h)) * 16384)
#define STAGE(P, BASE, kt) do { const char* _s = (const char*)(BASE) + (size_t)(kt) * SS_; char* _d = (P) + ldst; \
    __builtin_amdgcn_global_load_lds((const unsigned*)(_s + goffb), (LAS unsigned*)_d, 16, 0, 0); \
    __builtin_amdgcn_global_load_lds((const unsigned*)(_s + 8192 + goffb), (LAS unsigned*)(_d + 8192), 16, 0, 0); } while (0)
#define STAGEA(P, BASE, kt) do { const size_t SS_ = ssA; STAGE(P, BASE, kt); } while (0)
#define STAGEB(P, BASE, kt) do { const size_t SS_ = ssB; STAGE(P, BASE, kt); } while (0)
#define LDA(dst, b, h) _Pragma("unroll") for (int m = 0; m < 4; ++m) _Pragma("unroll") for (int k = 0; k < 2; ++k) \
    dst[m][k] = *(const s16x8*)(smem + a_rdo + ((b) * 2 + (h)) * 16384 + m * 2048 + k * 1024)
#define LDB(dst, b, h) _Pragma("unroll") for (int n = 0; n < 2; ++n) _Pragma("unroll") for (int k = 0; k < 2; ++k) \
    dst[n][k] = *(const s16x8*)(smem + b_rdo + ((b) * 2 + (h)) * 16384 + n * 2048 + k * 1024)
#define MMA(ai, bj, Ax, Bx) do { __builtin_amdgcn_s_setprio(1); \
    _Pragma("unroll") for (int m = 0; m < 4; ++m) _Pragma("unroll") for (int n = 0; n < 2; ++n) _Pragma("unroll") for (int k = 0; k < 2; ++k) \
      acc[ai][bj][m][n] = MFMA16(Bx[n][k], Ax[m][k], acc[ai][bj][m][n]); \
    __builtin_amdgcn_s_setprio(0); } while (0)

  for (int tile = vb; tile < ntTot; tile += G) {
    const int tn = tile % ntN, tm = tile / ntN;
    const int brow = tm * 256, bcol = tn * 256;
    const bf16* A0 = A + (size_t)brow * 64;
    const bf16* A1 = A0 + (size_t)128 * 64;
    const bf16* B0g = Bt + (size_t)bcol * 64;
    const bf16* B1g = B0g + (size_t)128 * 64;
    f32x4 acc[2][2][4][2];
#pragma unroll
    for (int a = 0; a < 2; ++a)
#pragma unroll
      for (int b = 0; b < 2; ++b)
#pragma unroll
        for (int m = 0; m < 4; ++m)
#pragma unroll
          for (int n = 0; n < 2; ++n) acc[a][b][m][n] = f32x4{0.f, 0.f, 0.f, 0.f};
    s16x8 At[4][2], B0[2][2], B1[2][2];
    __syncthreads();
    if (EPI != EPI_RES) {
      if (tid < 256) {
        const float* sq = ea.ssq + (size_t)(brow + tid) * 8;
        const f32x4 q0 = *(const f32x4*)sq, q1 = *(const f32x4*)(sq + 4);
        ssl[tid] = rsqrtf((((q0[0] + q0[1]) + (q0[2] + q0[3])) + ((q1[0] + q1[1]) + (q1[2] + q1[3]))) * (1.f / 1024.f) + EPS);
      }
    }
    STAGEB(SB(0, 0), B0g, 0); STAGEA(SA(0, 0), A0, 0);
    STAGEB(SB(0, 1), B1g, 0); STAGEA(SA(0, 1), A1, 0);
    if (wr == 1) BAR;
    WAIT_V(4); BAR;
    STAGEB(SB(1, 0), B0g, 1); STAGEA(SA(1, 0), A0, 1); STAGEB(SB(1, 1), B1g, 1);
    WAIT_V(6); BAR;
    int a_rdo = a_rd, b_rdo = b_rd;
    for (int t = 0; t < nt - 2; t += 2) {
      asm volatile("" : "+v"(a_rdo), "+v"(b_rdo));
      LDB(B0, 0, 0); SCHED; LDA(At, 0, 0); STAGEA(SA(1, 1), A1, t + 1);
      WAIT_L(8); BAR; WAIT_L(0); MMA(0, 0, At, B0); BAR; SCHED;
      LDB(B1, 0, 1); STAGEB(SB(0, 0), B0g, t + 2);
      BAR; WAIT_L(0); MMA(0, 1, At, B1); BAR;
      LDA(At, 0, 1); STAGEA(SA(0, 0), A0, t + 2);
      BAR; WAIT_L(0); MMA(1, 0, At, B0); BAR; SCHED;
      STAGEB(SB(0, 1), B1g, t + 2);
      WAIT_V(6); BAR; MMA(1, 1, At, B1); BAR;
      LDB(B0, 1, 0); SCHED; LDA(At, 1, 0); STAGEA(SA(0, 1), A1, t + 2);
      WAIT_L(8); BAR; WAIT_L(0); MMA(0, 0, At, B0); BAR; SCHED;
      LDB(B1, 1, 1); STAGEB(SB(1, 0), B0g, t + 3);
      BAR; WAIT_L(0); MMA(0, 1, At, B1); BAR;
      LDA(At, 1, 1); STAGEA(SA(1, 0), A0, t + 3);
      BAR; WAIT_L(0); MMA(1, 0, At, B0); BAR; SCHED;
      STAGEB(SB(1, 1), B1g, t + 3);
      WAIT_V(6); BAR; MMA(1, 1, At, B1); BAR;
    }
    asm volatile("" : "+v"(a_rdo), "+v"(b_rdo));
    { LDB(B0, 0, 0); LDA(At, 0, 0); STAGEA(SA(1, 1), A1, nt - 1);
      BAR; WAIT_L(0); MMA(0, 0, At, B0); BAR;
      LDB(B1, 0, 1); BAR; WAIT_L(0); MMA(0, 1, At, B1); BAR;
      LDA(At, 0, 1); WAIT_V(4); BAR; WAIT_L(0); MMA(1, 0, At, B0); MMA(1, 1, At, B1); BAR; }
    { LDB(B0, 1, 0); LDA(At, 1, 0); WAIT_V(2); BAR; WAIT_L(0); MMA(0, 0, At, B0); BAR;
      LDB(B1, 1, 1); WAIT_V(0); BAR; WAIT_L(0); MMA(0, 1, At, B1); BAR;
      LDA(At, 1, 1); BAR; WAIT_L(0); MMA(1, 0, At, B0); MMA(1, 1, At, B1); BAR; }
    if (wr == 0) BAR;
    for (int re = 0; re < ((EPI == EPI_RES) ? 1 : REP_EPI); ++re) {
    if (EPI == EPI_PROJ) {
      const int c = tn * 4 + wc;
      int nsel = 0; const float* gp = ea.g_nsa; float qs = 1.f;
      if (c < 4) { nsel = 1; gp = ea.g_nsa; qs = 0.125f * LOG2E; }
      else if (c == 6) { nsel = 1; gp = ea.g_nsa + 128; }
      else if (c == 8) { nsel = 1; gp = ea.g_nsa + 192; }
      else if (c >= 10 && c < 16) { nsel = 1; gp = ea.g_dil; qs = 0.125f * LOG2E; }
      else if (c >= 16 && c < 22) { nsel = 1; gp = ea.g_dil + 64; }
      else if (c >= 28 && c < 34) { qs = 0.125f * LOG2E; }
      const bool dperm = (c >= 10 && c < 28);
      const int sh = dperm ? ((((c - 10) % 6) >> 1) * 2) : 0;
      float gv[2][2][4];
#pragma unroll
      for (int bj = 0; bj < 2; ++bj)
#pragma unroll
        for (int n = 0; n < 2; ++n) {
          f32x4 g4 = *(const f32x4*)(gp + bj * 32 + fq * 8 + n * 4);
#pragma unroll
          for (int j = 0; j < 4; ++j) gv[bj][n][j] = nsel ? g4[j] * qs : qs;
        }
#pragma unroll
      for (int ai = 0; ai < 2; ++ai)
#pragma unroll
        for (int m = 0; m < 4; ++m) {
          const int row = brow + ai * 128 + wr * 64 + m * 16 + fr;
          const float rs = ssl[ai * 128 + wr * 64 + m * 16 + fr];
          float v[2][2][4]; float ss = 0.f;
#pragma unroll
          for (int bj = 0; bj < 2; ++bj)
#pragma unroll
            for (int n = 0; n < 2; ++n)
#pragma unroll
              for (int j = 0; j < 4; ++j) { float x = acc[ai][bj][m][n][j] * rs; v[bj][n][j] = x; ss += x * x; }
          float rr = 1.f;
          if (nsel) {
            ss += __shfl_xor(ss, 16); ss += __shfl_xor(ss, 32);
            rr = rsqrtf(ss * (1.f / 64.f) + EPS);
          }
          int grow = row;
          if (dperm) {
            int b = row >> 13, t = row & (SEQ - 1);
            grow = b * SEQ + (t & ((1 << sh) - 1)) * (SEQ >> sh) + (t >> sh);
          }
          bf16* orow = ea.outb + ((size_t)c * NT + grow) * 64 + fq * 8;
#pragma unroll
          for (int bj = 0; bj < 2; ++bj) {
            u32x4 o;
            o[0] = pack2(v[bj][0][0] * rr * gv[bj][0][0], v[bj][0][1] * rr * gv[bj][0][1]);
            o[1] = pack2(v[bj][0][2] * rr * gv[bj][0][2], v[bj][0][3] * rr * gv[bj][0][3]);
            o[2] = pack2(v[bj][1][0] * rr * gv[bj][1][0], v[bj][1][1] * rr * gv[bj][1][1]);
            o[3] = pack2(v[bj][1][2] * rr * gv[bj][1][2], v[bj][1][3] * rr * gv[bj][1][3]);
            *(u32x4*)(orow + bj * 32) = o;
          }
        }
    } else if (EPI == EPI_UP) {
#pragma unroll
      for (int ai = 0; ai < 2; ++ai)
#pragma unroll
        for (int m = 0; m < 4; ++m) {
          const int row = brow + ai * 128 + wr * 64 + m * 16 + fr;
          const float rs = ssl[ai * 128 + wr * 64 + m * 16 + fr];
          bf16* orow = ea.outb + blk(NT, row, bcol + wc * 32 + fq * 8);
#pragma unroll
          for (int bj = 0; bj < 2; ++bj) {
            u32x4 o;
#pragma unroll
            for (int n = 0; n < 2; ++n) {
              float x0 = fmaxf(acc[ai][bj][m][n][0] * rs, 0.f), x1 = fmaxf(acc[ai][bj][m][n][1] * rs, 0.f);
              float x2 = fmaxf(acc[ai][bj][m][n][2] * rs, 0.f), x3 = fmaxf(acc[ai][bj][m][n][3] * rs, 0.f);
              o[2 * n] = pack2(x0 * x0, x1 * x1); o[2 * n + 1] = pack2(x2 * x2, x3 * x3);
            }
            *(u32x4*)(orow + (size_t)bj * 2 * NT * 64) = o;
          }
        }
    } else {
      const bool of32 = (ea.outf != nullptr);
      u32x4 ru[2][4][2];
#pragma unroll
      for (int ai = 0; ai < 2; ++ai)
#pragma unroll
        for (int m = 0; m < 4; ++m)
#pragma unroll
          for (int bj = 0; bj < 2; ++bj)
            ru[ai][m][bj] = *(const u32x4*)(ea.outb + blk(NT, brow + ai * 128 + wr * 64 + m * 16 + fr, bcol + wc * 32 + bj * 128 + fq * 8));
      __builtin_amdgcn_sched_barrier(0);
#pragma unroll
      for (int ai = 0; ai < 2; ++ai) {
#pragma unroll
        for (int m = 0; m < 4; ++m) {
          const int lr = ai * 128 + wr * 64 + m * 16 + fr;
          float ss = 0.f;
#pragma unroll
          for (int bj = 0; bj < 2; ++bj) {
            const int col = bcol + wc * 32 + bj * 128 + fq * 8;
            const u32x4 u = ru[ai][m][bj];
            const f32x4 r0 = f32x4{__uint_as_float(u[0] << 16), __uint_as_float(u[0] & 0xffff0000u), __uint_as_float(u[1] << 16), __uint_as_float(u[1] & 0xffff0000u)};
            const f32x4 r1 = f32x4{__uint_as_float(u[2] << 16), __uint_as_float(u[2] & 0xffff0000u), __uint_as_float(u[3] << 16), __uint_as_float(u[3] & 0xffff0000u)};
            const f32x4 v0 = acc[ai][bj][m][0] + r0, v1 = acc[ai][bj][m][1] + r1;
            if (of32) {
              float* op = ea.outf + (size_t)(brow + lr) * DM + col;
              *(f32x4*)op = v0; *(f32x4*)(op + 4) = v1;
            } else {
              u32x4 o;
              o[0] = pack2(v0[0], v0[1]); o[1] = pack2(v0[2], v0[3]); o[2] = pack2(v1[0], v1[1]); o[3] = pack2(v1[2], v1[3]);
              *(u32x4*)(ea.outb + blk(NT, brow + lr, col)) = o;
            }
            ss += ((v0[0] * v0[0] + v0[1] * v0[1]) + (v0[2] * v0[2] + v0[3] * v0[3])) + ((v1[0] * v1[0] + v1[1] * v1[1]) + (v1[2] * v1[2] + v1[3] * v1[3]));
          }
          ss += __shfl_xor(ss, 16); ss += __shfl_xor(ss, 32);
          if (fq == 0) ssl[wc * 256 + lr] = ss;
        }
      }
      __syncthreads();
      if (tid < 256) ea.ssq_out[(size_t)(brow + tid) * 8 + tn] = (ssl[tid] + ssl[256 + tid]) + (ssl[512 + tid] + ssl[768 + tid]);
    }
    }
  }
}

DI float gelu_tanh(float x) {
  float u = 0.7978845608028654f * (x + 0.044715f * x * x * x);
  float e = __expf(2.f * u);
  float th = 1.f - 2.f / (e + 1.f);
  return 0.5f * x * (1.f + th);
}

__device__ void compress_item(const Params& p, int l, int item, char* smem) {
  const int tid = tid_opaque(), w = tid >> 6, lane = tid & 63, fr = lane & 15, fq = lane >> 4;
  const int b = item >> 6, c = (item >> 5) & 1, nt = item & 31;
  const bf16* proj = (const bf16*)(p.ws + OFF_PROJ);
  const bf16* w1t = (const bf16*)(p.ws + OFF_W1T) + ((size_t)l * 2 + c) * 128 * 2048;
  const bf16* w2t = (const bf16*)(p.ws + OFF_W2T) + ((size_t)l * 2 + c) * 64 * 128;
  const float* pe = p.pe + ((size_t)l * 2 + c) * 32 * 64;
  float* part = (float*)smem;
  bf16* hid = (bf16*)(smem + 8 * 16 * 132 * 4);
  float* outf = (float*)(smem + 8 * 16 * 132 * 4 + 16 * 136 * 2);
  __syncthreads();
  const int n = nt * 16 + fr;
  f32x4 acc[8];
#pragma unroll
  for (int q = 0; q < 8; ++q) acc[q] = f32x4{0.f, 0.f, 0.f, 0.f};
#pragma unroll
  for (int kp = 0; kp < 4; ++kp) {
    s16x8 a8[2], b8[2][8]; f32x4 p0[2], p1[2];
#pragma unroll
    for (int u = 0; u < 2; ++u) {
      const int ks = w * 8 + kp * 2 + u;
      int tok = 16 * n + (ks >> 1); if (tok > SEQ - 1) tok = SEQ - 1;
      const int d0 = (ks & 1) * 32 + fq * 8;
      a8[u] = *(const s16x8*)(proj + ((size_t)(4 + c) * NT + (size_t)b * SEQ + tok) * 64 + d0);
      const float* pp = pe + (ks >> 1) * 64 + d0;
      p0[u] = *(const f32x4*)pp; p1[u] = *(const f32x4*)(pp + 4);
#pragma unroll
      for (int q = 0; q < 8; ++q) b8[u][q] = *(const s16x8*)(w1t + (size_t)(q * 16 + fr) * 2048 + ks * 32 + fq * 8);
    }
    __builtin_amdgcn_sched_barrier(0);
#pragma unroll
    for (int u = 0; u < 2; ++u) {
      u32x4 au;
      au[0] = pack2(bf2f((unsigned short)a8[u][0]) + p0[u][0], bf2f((unsigned short)a8[u][1]) + p0[u][1]);
      au[1] = pack2(bf2f((unsigned short)a8[u][2]) + p0[u][2], bf2f((unsigned short)a8[u][3]) + p0[u][3]);
      au[2] = pack2(bf2f((unsigned short)a8[u][4]) + p1[u][0], bf2f((unsigned short)a8[u][5]) + p1[u][1]);
      au[3] = pack2(bf2f((unsigned short)a8[u][6]) + p1[u][2], bf2f((unsigned short)a8[u][7]) + p1[u][3]);
      const s16x8 af = __builtin_bit_cast(s16x8, au);
#pragma unroll
      for (int q = 0; q < 8; ++q) acc[q] = MFMA16(af, b8[u][q], acc[q]);
    }
    __builtin_amdgcn_sched_barrier(0);
  }
#pragma unroll
  for (int q = 0; q < 8; ++q)
#pragma unroll
    for (int j = 0; j < 4; ++j) part[(w * 16 + fq * 4 + j) * 132 + q * 16 + fr] = acc[q][j];
  __syncthreads();
  for (int e = tid; e < 16 * 128; e += NTHR) {
    const int row = e >> 7, col = e & 127;
    float s = 0.f;
#pragma unroll
    for (int ww = 0; ww < 8; ++ww) s += part[(ww * 16 + row) * 132 + col];
    hid[row * 136 + col] = f2bf(gelu_tanh(s));
  }
  __syncthreads();
  if (w < 4) {
    f32x4 a2 = f32x4{0.f, 0.f, 0.f, 0.f};
#pragma unroll
    for (int ks = 0; ks < 4; ++ks) {
      s16x8 a8 = *(const s16x8*)(hid + fr * 136 + ks * 32 + fq * 8);
      s16x8 b8 = *(const s16x8*)(w2t + (size_t)(w * 16 + fr) * 128 + ks * 32 + fq * 8);
      a2 = MFMA16(a8, b8, a2);
    }
#pragma unroll
    for (int j = 0; j < 4; ++j) outf[(fq * 4 + j) * 65 + w * 16 + fr] = a2[j];
  }
  __syncthreads();
  if (tid < 256) {
    int row = tid >> 4, c4 = (tid & 15) * 4;
    float v[4]; float ss = 0.f;
#pragma unroll
    for (int j = 0; j < 4; ++j) { v[j] = outf[row * 65 + c4 + j]; ss += v[j] * v[j]; }
    ss += __shfl_xor(ss, 1); ss += __shfl_xor(ss, 2); ss += __shfl_xor(ss, 4); ss += __shfl_xor(ss, 8);
    int nrow = nt * 16 + row;
    if (c == 0) {
      float rr = rsqrtf(ss * (1.f / 64.f) + EPS);
      const float* g = p.g_nsa + (size_t)l * 256 + 64;
#pragma unroll
      for (int j = 0; j < 4; ++j) v[j] = v[j] * rr * g[c4 + j];
    }
    if (nrow >= 511) { v[0] = v[1] = v[2] = v[3] = 0.f; }
    bf16* dst = (bf16*)(p.ws + (c == 0 ? OFF_KC : OFF_VC)) + ((size_t)b * 512 + nrow) * 64 + c4;
    *(uint2*)dst = make_uint2(pack2(v[0], v[1]), pack2(v[2], v[3]));
  }
}

DI float quad_sum(float x) {
  float y = x + __builtin_bit_cast(float, __builtin_amdgcn_update_dpp(0, __builtin_bit_cast(int, x), 0xB1, 0xF, 0xF, true));
  return y + __builtin_bit_cast(float, __builtin_amdgcn_update_dpp(0, __builtin_bit_cast(int, y), 0x4E, 0xF, 0xF, true));
}
DI float fexp2(float x) { return __builtin_amdgcn_exp2f(x); }
DI float flog2(float x) { return __builtin_amdgcn_logf(x); }

DI void kv_load(int tid, const bf16* Kb, const bf16* Vb, size_t stride, int row0, s16x8& kr, s16x8& vr) {
  int row = tid >> 3, ch = (tid & 7) * 8;
  kr = *(const s16x8*)(Kb + (size_t)(row0 + row) * stride + ch);
  if (Vb) vr = *(const s16x8*)(Vb + (size_t)(row0 + row) * stride + ch);
}
DI void kv_store(int tid, char* smem, int buf, bool hasV, const s16x8& kr, const s16x8& vr) {
  int row = tid >> 3, ch = (tid & 7) * 16;
  *(s16x8*)(smem + buf * L_KVB + row * KROW + ch) = kr;
  if (hasV) *(s16x8*)(smem + buf * L_KVB + L_VS + row * KROW + ch) = vr;
}
DI void qk_tile(int tid, const char* kbuf, const s16x8 (&qf)[4], f32x16 (&S)[2]) {
  const int lane = tid & 63, r = lane & 31, half = lane >> 5;
#pragma unroll
  for (int kt = 0; kt < 2; ++kt) {
#pragma unroll
    for (int i = 0; i < 16; ++i) S[kt][i] = 0.f;
#pragma unroll
    for (int ks = 0; ks < 4; ++ks) {
      s16x8 kf = *(const s16x8*)(kbuf + (kt * 32 + r) * KROW + (ks * 16 + half * 8) * 2);
      S[kt] = MFMA32(kf, qf[ks], S[kt]);
    }
  }
}
DI void pv_tile(int tid, const char* vbuf, const f32x16 (&P)[2], f32x16 (&O)[2]) {
  const int lane = tid & 63;
  const int g4 = lane >> 4, q4 = (lane & 15) >> 2, p4 = lane & 3;
#pragma unroll
  for (int kt = 0; kt < 2; ++kt) {
#pragma unroll
    for (int s = 0; s < 2; ++s) {
      u32x4 pk;
      pk[0] = pack2(P[kt][8 * s + 0], P[kt][8 * s + 1]);
      pk[1] = pack2(P[kt][8 * s + 2], P[kt][8 * s + 3]);
      pk[2] = pack2(P[kt][8 * s + 4], P[kt][8 * s + 5]);
      pk[3] = pack2(P[kt][8 * s + 6], P[kt][8 * s + 7]);
      s16x8 pb = __builtin_bit_cast(s16x8, pk);
#pragma unroll
      for (int dt = 0; dt < 2; ++dt) {
        int c0 = dt * 32 + 16 * (g4 & 1);
        int r0 = kt * 32 + 16 * s + 4 * (g4 >> 1);
        const char* a0 = vbuf + (r0 + q4) * KROW + (c0 + 4 * p4) * 2;
        s16x4 lo = __builtin_amdgcn_ds_read_tr16_b64_v4i16((__attribute__((address_space(3))) s16x4*)(a0));
        s16x4 hi = __builtin_amdgcn_ds_read_tr16_b64_v4i16((__attribute__((address_space(3))) s16x4*)(a0 + 8 * KROW));
        s16x8 vf = __builtin_shufflevector(lo, hi, 0, 1, 2, 3, 4, 5, 6, 7);
        O[dt] = MFMA32(vf, pb, O[dt]);
      }
    }
  }
}

template <class K0Fn, class CFn, class StopFn>
DI void kv_pipeline(int tid, const bf16* Kb, const bf16* Vb, size_t stride, int ntiles, K0Fn k0fn, CFn compute, StopFn stop, char* smem) {
  s16x8 k0r, v0r = s16x8{0, 0, 0, 0, 0, 0, 0, 0}, k1r, v1r = s16x8{0, 0, 0, 0, 0, 0, 0, 0};
  const bool hasV = (Vb != nullptr);
  if (ntiles > 0) kv_load(tid, Kb, Vb, stride, k0fn(0), k0r, v0r);
  if (ntiles > 1) kv_load(tid, Kb, Vb, stride, k0fn(1), k1r, v1r);
  __syncthreads();
  if (ntiles > 0) kv_store(tid, smem, 0, hasV, k0r, v0r);
  if (ntiles > 2) kv_load(tid, Kb, Vb, stride, k0fn(2), k0r, v0r);
  for (int idx = 0; idx < ntiles; idx += 2) {
    __syncthreads();
    if (stop()) break;
    if (idx + 1 < ntiles) kv_store(tid, smem, 1, hasV, k1r, v1r);
    if (idx + 3 < ntiles) kv_load(tid, Kb, Vb, stride, k0fn(idx + 3), k1r, v1r);
    compute(idx, k0fn(idx), 0);
    if (idx + 1 >= ntiles) break;
    __syncthreads();
    if (stop()) break;
    if (idx + 2 < ntiles) kv_store(tid, smem, 0, hasV, k0r, v0r);
    if (idx + 4 < ntiles) kv_load(tid, Kb, Vb, stride, k0fn(idx + 4), k0r, v0r);
    compute(idx + 1, k0fn(idx + 1), 1);
  }
}

DI void softmax_step(int tid, int cls, f32x16 (&S)[2], f32x16 (&O)[2], float& m, float& l, int k0, int qpos, float slope2,
                     int kmul, int kadd, int W, bool extra) {
  const int half = (tid & 63) >> 5;
  const int dbase = qpos - (k0 + 4 * half) * kmul - kadd;
  float mx = NEGB;
  float c;
  if (cls != 4) {
    const float sk = slope2 * (float)kmul, b0 = -slope2 * (float)dbase;
    if (cls == 1) {
#pragma unroll
      for (int kt = 0; kt < 2; ++kt)
#pragma unroll
        for (int i = 0; i < 16; ++i) {
          float t = fmaf(sk, (float)(kt * 32 + (i & 3) + 8 * (i >> 2)), S[kt][i]);
          S[kt][i] = t;
          mx = fmaxf(mx, t);
        }
    } else if (cls == 2) {
      const int hi = extra ? dbase : -1;
#pragma unroll
      for (int kt = 0; kt < 2; ++kt)
#pragma unroll
        for (int i = 0; i < 16; ++i) {
          const int off = kt * 32 + (i & 3) + 8 * (i >> 2);
          float t = fmaf(sk, (float)off, S[kt][i]);
          t = (off * kmul <= hi) ? t : NEGB;
          S[kt][i] = t;
          mx = fmaxf(mx, t);
        }
    } else {
      const int lo = extra ? dbase - W : 0x7fffffff;
#pragma unroll
      for (int kt = 0; kt < 2; ++kt)
#pragma unroll
        for (int i = 0; i < 16; ++i) {
          const int off = kt * 32 + (i & 3) + 8 * (i >> 2);
          float t = fmaf(sk, (float)off, S[kt][i]);
          t = (off * kmul >= lo) ? t : NEGB;
          S[kt][i] = t;
          mx = fmaxf(mx, t);
        }
    }
    mx += b0;
    mx = fmaxf(mx, __shfl_xor(mx, 32));
    if (__any(mx > m + 8.f)) {
      float mn = fmaxf(m, mx), alpha = fexp2(m - mn);
      m = mn; l *= alpha;
#pragma unroll
      for (int dt = 0; dt < 2; ++dt)
#pragma unroll
        for (int i = 0; i < 16; ++i) O[dt][i] *= alpha;
    }
    c = fmaxf(m, -1e20f) - b0;
  } else {
#pragma unroll
    for (int kt = 0; kt < 2; ++kt)
#pragma unroll
      for (int i = 0; i < 16; ++i) {
        int d = dbase - (kt * 32 + (i & 3) + 8 * (i >> 2)) * kmul;
        bool valid = extra && ((unsigned)d <= (unsigned)W);
        float s2 = valid ? fmaf(-slope2, (float)d, S[kt][i]) : NEGB;
        S[kt][i] = s2;
        mx = fmaxf(mx, s2);
      }
    mx = fmaxf(mx, __shfl_xor(mx, 32));
    if (__any(mx > m + 8.f)) {
      float mn = fmaxf(m, mx), alpha = fexp2(m - mn);
      m = mn; l *= alpha;
#pragma unroll
      for (int dt = 0; dt < 2; ++dt)
#pragma unroll
        for (int i = 0; i < 16; ++i) O[dt][i] *= alpha;
    }
    c = fmaxf(m, -1e20f);
  }
  float ps = 0.f;
#pragma unroll
  for (int kt = 0; kt < 2; ++kt)
#pragma unroll
    for (int i = 0; i < 16; ++i) {
      float pv = fexp2(S[kt][i] - c);
      S[kt][i] = pv;
      ps += pv;
    }
  l += ps;
}

DI int tile_class(int qmin, int qmax, int k0, int kmul, int kadd, int W) {
  const int kpmin = k0 * kmul + kadd, kpmax = (k0 + 63) * kmul + kadd;
  const int dmin = qmin - kpmax, dmax = qmax - kpmin;
  if (dmax < 0 || dmin > W) return 0;
  if (dmin >= 0) return (dmax <= W) ? 1 : 3;
  return (dmax <= W) ? 2 : 4;
}

template <class K0Fn, class ExFn>
DI void flash_softmax(int tid, const bf16* Kb, const bf16* Vb, size_t kvstride, int ntiles, K0Fn k0fn, ExFn exfn,
                      const s16x8 (&qf)[4], int qpos, int qmin, int qmax, float slope2, int kmul, int kadd, int W,
                      f32x16 (&O)[2], float& m, float& l, char* smem) {
  kv_pipeline(tid, Kb, Vb, kvstride, ntiles, k0fn,
              [&](int idx, int k0, int buf) {
                int cls = tile_class(qmin, qmax, k0, kmul, kadd, W);
                const bool ex = exfn(k0);
                if (!__any(ex)) cls = 0;
                else if (cls == 1 && !__all(ex)) cls = 2;
                if (cls != 0) {
                  f32x16 S[2];
                  qk_tile(tid, smem + buf * L_KVB, qf, S);
                  softmax_step(tid, cls, S, O, m, l, k0, qpos, slope2, kmul, kadd, W, ex);
                  pv_tile(tid, smem + buf * L_KVB + L_VS, S, O);
                }
              },
              []() { return false; }, smem);
}

DI void load_q(int tid, const bf16* qrow, s16x8 (&qf)[4]) {
  const int half = (tid & 63) >> 5;
#pragma unroll
  for (int ks = 0; ks < 4; ++ks) qf[ks] = *(const s16x8*)(qrow + ks * 16 + half * 8);
}
DI void zero_state(f32x16 (&O)[2], float& m, float& l) {
#pragma unroll
  for (int dt = 0; dt < 2; ++dt)
#pragma unroll
    for (int i = 0; i < 16; ++i) O[dt][i] = 0.f;
  m = NEGB; l = 0.f;
}
DI float sigmoidf_(float x) { return 1.f / (1.f + __expf(-x)); }

__device__ void nsa_item(const Params& p, int item, char* smem) {
  const int tid = tid_opaque(), w = tid >> 6, lane = tid & 63, r = lane & 31, half = lane >> 5;
  const int b = item >> 7, t0 = (item & 127) * 64;
  const int tq = w * 8 + (r >> 2), h = r & 3, t = t0 + tq;
  const int qmin = t0 + w * 8, qmax = qmin + 7;
  const bf16* proj = (const bf16*)(p.ws + OFF_PROJ);
  const bf16* pb = proj + (size_t)b * SEQ * 64;
  const size_t CH = (size_t)NT * 64;
  const bf16* qrow = pb + h * CH + (size_t)t * 64;
  float* imp = (float*)(smem + L_IMP);
  float* impe = (float*)(smem + L_IMPE);
  unsigned* selm = (unsigned*)(smem + L_SELM);
  int* tlist = (int*)(smem + L_LIST);
  const float slope2 = fexp2(-0.8f * (float)(h + 7)) * LOG2E;
  float gate[3];
#pragma unroll
  for (int br = 0; br < 3; ++br) gate[br] = sigmoidf_(bf2f(pb[46 * CH + (size_t)t * 64 + h * 3 + br]));
  s16x8 qf[4];
  load_q(tid, qrow, qf);
  f32x16 Of[2];
#pragma unroll
  for (int dt = 0; dt < 2; ++dt)
#pragma unroll
    for (int i = 0; i < 16; ++i) Of[dt][i] = 0.f;

  __syncthreads();
  for (int i = tid; i < 64 * IMPW; i += NTHR) { imp[i] = 0.f; impe[i] = 0.f; }

  const bf16* kc = (const bf16*)(p.ws + OFF_KC) + (size_t)b * 512 * 64;
  const bf16* vc = (const bf16*)(p.ws + OFF_VC) + (size_t)b * 512 * 64;
  const int ntc = ((t0 >> 4) + 2) / 64 + 1;
  f32x16 O[2]; float m, l;
  for (int q_ = 0; q_ < REP_CMPA; ++q_) {
  zero_state(O, m, l);
  flash_softmax(tid, kc, vc, 64, ntc, [](int i) { return i * 64; }, [](int) { return true; }, qf, t, qmin, qmax, slope2, 16, 31, 1 << 30, O, m, l, smem);
  }
  float lt = l + __shfl_xor(l, 32);
  {
    float sc = gate[0] / fmaxf(lt, 1e-30f);
#pragma unroll
    for (int dt = 0; dt < 2; ++dt)
#pragma unroll
      for (int i = 0; i < 16; ++i) Of[dt][i] += sc * O[dt][i];
  }
  {
    const float linv = 1.f / fmaxf(lt, 1e-30f);
    const float mc = fmaxf(m, -1e20f);
    kv_pipeline(tid, kc, nullptr, 64, ntc, [](int i) { return i * 64; },
                [&](int idx, int k0, int buf) {
                  const int cls = tile_class(qmin, qmax, k0, 16, 31, 1 << 30);
                  float Gq[2][4], El[2][4];
                  if (cls != 0) {
                    f32x16 S[2];
                    qk_tile(tid, smem + buf * L_KVB, qf, S);
                    const int dbase = t - (k0 + 4 * half) * 16 - 31;
#pragma unroll
                    for (int kt = 0; kt < 2; ++kt)
#pragma unroll
                      for (int g = 0; g < 4; ++g) {
                        float qs = 0.f, last = 0.f;
#pragma unroll
                        for (int e = 0; e < 4; ++e) {
                          int i = 4 * g + e;
                          int d = dbase - (kt * 32 + e + 8 * g) * 16;
                          float s2 = fmaf(-slope2, (float)d, S[kt][i]);
                          if (cls != 1) s2 = (d >= 0) ? s2 : NEGB;
                          float pv = fexp2(s2 - mc) * linv;
                          qs += pv; last = pv;
                        }
                        Gq[kt][g] = quad_sum(qs); El[kt][g] = quad_sum(last);
                      }
                    if (h == 0) {
#pragma unroll
                      for (int kt = 0; kt < 2; ++kt)
#pragma unroll
                        for (int g = 0; g < 4; ++g) { int j = 16 * idx + kt * 8 + 2 * g + half; imp[tq * IMPW + j] = Gq[kt][g]; impe[tq * IMPW + j + 1] = El[kt][g]; }
                    }
                  }
                },
                []() { return false; }, smem);
  }
  __syncthreads();
  {
    const int tk = lane >> 3, sub = lane & 7;
    const int tq2 = w * 8 + tk, t2 = t0 + tq2, cur = t2 >> 6;
    unsigned long long key[16];
#pragma unroll
    for (int e = 0; e < 16; ++e) {
      int j = sub * 16 + e;
      float v = imp[tq2 * IMPW + j] + impe[tq2 * IMPW + j];
      bool forced = (j == 0) || (j == cur) || (j == cur - 1);
      if (forced) v += 1e4f;
      bool vis = (64 * j <= t2);
      unsigned hi = vis ? (__float_as_uint(v) + 1u) : 0u;
      key[e] = ((unsigned long long)hi << 32) | (unsigned)(128 - j);
    }
    unsigned mk[4] = {0u, 0u, 0u, 0u};
    for (int it = 0; it < 16; ++it) {
      unsigned long long best = key[0];
#pragma unroll
      for (int e = 1; e < 16; ++e) best = (key[e] > best) ? key[e] : best;
#define TOPK_DPP_STEP(CTRL) { \
        const unsigned lo_ = (unsigned)__builtin_amdgcn_update_dpp(0, (int)(unsigned)best, CTRL, 0xF, 0xF, true); \
        const unsigned hi_ = (unsigned)__builtin_amdgcn_update_dpp(0, (int)(unsigned)(best >> 32), CTRL, 0xF, 0xF, true); \
        const unsigned long long ob_ = ((unsigned long long)hi_ << 32) | lo_; \
        best = (ob_ > best) ? ob_ : best; }
      TOPK_DPP_STEP(0xB1) TOPK_DPP_STEP(0x4E) TOPK_DPP_STEP(0x141)
#undef TOPK_DPP_STEP
      int js = 128 - (int)(best & 255ull);
      if ((best >> 32) != 0ull) {
#pragma unroll
        for (int q = 0; q < 4; ++q) if ((js >> 5) == q) mk[q] |= 1u << (js & 31);
      }
#pragma unroll
      for (int e = 0; e < 16; ++e) if ((unsigned)key[e] == (unsigned)best) key[e] = 0ull;
    }
    if (sub == 0) {
#pragma unroll
      for (int q = 0; q < 4; ++q) selm[tq2 * 4 + q] = mk[q];
    }
  }
  __syncthreads();
  if (w == 0) {
    unsigned um[4];
#pragma unroll
    for (int q = 0; q < 4; ++q) {
      unsigned v = selm[lane * 4 + q];
#pragma unroll
      for (int o = 1; o < 64; o <<= 1) v |= __shfl_xor(v, o);
      um[q] = v;
    }
    const bool b0 = ((lane < 32 ? um[0] : um[1]) >> (lane & 31)) & 1u;
    const bool b1 = ((lane < 32 ? um[2] : um[3]) >> (lane & 31)) & 1u;
    const unsigned long long m0 = __ballot(b0), m1 = __ballot(b1);
    const unsigned long long below = (lane == 0) ? 0ull : (~0ull >> (64 - lane));
    const int c0 = __popcll(m0);
    if (b0) tlist[1 + __popcll(m0 & below)] = lane * 64;
    if (b1) tlist[1 + c0 + __popcll(m1 & below)] = (lane + 64) * 64;
    if (lane == 0) tlist[0] = c0 + __popcll(m1);
  }
  __syncthreads();
  {
    const int nsel = tlist[0];
    const unsigned* myselm = selm + tq * 4;
    for (int q_ = 0; q_ < REP_SEL; ++q_) {
    zero_state(O, m, l);
    flash_softmax(tid, pb + 6 * CH, pb + 7 * CH, 64, nsel, [&](int i) { return tlist[1 + i]; },
                  [&](int k0) { int j = k0 >> 6; return ((myselm[j >> 5] >> (j & 31)) & 1u) != 0u; },
                  qf, t, qmin, qmax, slope2, 1, 0, 1 << 30, O, m, l, smem);
    }
    float lt2 = l + __shfl_xor(l, 32);
    float sc = gate[1] / fmaxf(lt2, 1e-30f);
#pragma unroll
    for (int dt = 0; dt < 2; ++dt)
#pragma unroll
      for (int i = 0; i < 16; ++i) Of[dt][i] += sc * O[dt][i];
  }
  {
    int kfirst = t0 - 511; if (kfirst < 0) kfirst = 0;
    const int tfirst = kfirst >> 6, tlast = (t0 + 63) >> 6;
    for (int q_ = 0; q_ < REP_WIN; ++q_) {
    zero_state(O, m, l);
    flash_softmax(tid, pb + 8 * CH, pb + 9 * CH, 64, tlast - tfirst + 1, [&](int i) { return (tfirst + i) * 64; }, [](int) { return true; },
                  qf, t, qmin, qmax, slope2, 1, 0, 511, O, m, l, smem);
    }
    float lt3 = l + __shfl_xor(l, 32);
    float sc = gate[2] / fmaxf(lt3, 1e-30f);
#pragma unroll
    for (int dt = 0; dt < 2; ++dt)
#pragma unroll
      for (int i = 0; i < 16; ++i) Of[dt][i] += sc * O[dt][i];
  }
  bf16* cat = (bf16*)(p.ws + OFF_CAT) + ((size_t)h * NT + (size_t)b * SEQ + t) * 64;
#pragma unroll
  for (int dt = 0; dt < 2; ++dt)
#pragma unroll
    for (int g = 0; g < 4; ++g) {
      int d = dt * 32 + 8 * g + 4 * half;
      *(uint2*)(cat + d) = make_uint2(pack2(Of[dt][4 * g], Of[dt][4 * g + 1]), pack2(Of[dt][4 * g + 2], Of[dt][4 * g + 3]));
    }
}

__device__ void dil_item(const Params& p, int item, char* smem) {
  const int tid = tid_opaque(), w = tid >> 6, lane = tid & 63, r = lane & 31, half = lane >> 5;
  const int ti = item & 31, hh = (item >> 5) & 1, g = (item >> 6) % 3, b = item / 192;
  const int sh = 2 * g, rr = 1 << sh, nper = SEQ >> sh, tpc = nper >> 8;
  const int c = ti / tpc, i0 = (ti % tpc) * 256;
  const bf16* pb = (const bf16*)(p.ws + OFF_PROJ) + ((size_t)b * SEQ + (size_t)c * nper) * 64;
  const size_t CH = (size_t)NT * 64;
  const int head = g * 2 + hh;
  const int qi = i0 + w * 32 + r;
  const int qmin = i0 + w * 32, qmax = qmin + 31;
  s16x8 qf[4];
  load_q(tid, pb + (10 + head) * CH + (size_t)qi * 64, qf);
  const float slope2 = fexp2(-0.8f * (float)(head + 1)) * (float)rr * LOG2E;
  f32x16 O[2]; float m, l;
  zero_state(O, m, l);
  const int kfirst = (i0 >= 128) ? i0 - 128 : 0;
  const int nt = (i0 + 256 - kfirst) >> 6;
  {
    const bf16* Kb = pb + (16 + head) * CH;
    const bf16* Vb = pb + (22 + head) * CH;
    s16x8 kr[6], vr[6];
#pragma unroll
    for (int j = 0; j < 6; ++j)
      if (j < nt) kv_load(tid, Kb, Vb, 64, kfirst + j * 64, kr[j], vr[j]);
    __syncthreads();
#pragma unroll
    for (int j = 0; j < 6; ++j)
      if (j < nt) kv_store(tid, smem, j, true, kr[j], vr[j]);
    __syncthreads();
#pragma unroll 1
    for (int j = 0; j < nt; ++j) {
      const int k0 = kfirst + j * 64;
      const int cls = tile_class(qmin, qmax, k0, 1, 0, 128);
      if (cls != 0) {
        f32x16 S[2];
        qk_tile(tid, smem + j * L_KVB, qf, S);
        softmax_step(tid, cls, S, O, m, l, k0, qi, slope2, 1, 0, 128, true);
        pv_tile(tid, smem + j * L_KVB + L_VS, S, O);
      }
    }
  }
  float lt = l + __shfl_xor(l, 32);
  float linv = 1.f / fmaxf(lt, 1e-30f);
  const size_t prow = ((size_t)(b * 3 + g) * SEQ + (size_t)c * nper + qi);
  float* od = (float*)(p.ws + OFF_DILO) + (prow * 2 + hh) * 64;
#pragma unroll
  for (int dt = 0; dt < 2; ++dt)
#pragma unroll
    for (int q = 0; q < 4; ++q) {
      int d = dt * 32 + 8 * q + 4 * half;
      *(f32x4*)(od + d) = f32x4{O[dt][4 * q] * linv, O[dt][4 * q + 1] * linv, O[dt][4 * q + 2] * linv, O[dt][4 * q + 3] * linv};
    }
  if (half == 0) ((float*)(p.ws + OFF_DILL))[prow * 2 + hh] = m + flog2(fmaxf(lt, 1e-30f));
}

__device__ void dilc_item(const Params& p, int item) {
  const int tid = tid_opaque();
  const int tokg = item * 64 + (tid >> 3), hh = (tid >> 2) & 1, d0 = (tid & 3) * 16;
  const int b = tokg >> 13, t = tokg & (SEQ - 1);
  const float* dilo = (const float*)(p.ws + OFF_DILO);
  const float* dill = (const float*)(p.ws + OFF_DILL);
  float ls[3]; const float* op[3];
#pragma unroll
  for (int g = 0; g < 3; ++g) {
    int sh = 2 * g;
    size_t prow = (size_t)(b * 3 + g) * SEQ + (size_t)(t & ((1 << sh) - 1)) * (SEQ >> sh) + (t >> sh);
    ls[g] = dill[prow * 2 + hh];
    op[g] = dilo + (prow * 2 + hh) * 64 + d0;
  }
  float mx = fmaxf(ls[0], fmaxf(ls[1], ls[2]));
  float e0 = fexp2(ls[0] - mx), e1 = fexp2(ls[1] - mx), e2 = fexp2(ls[2] - mx);
  float inv = 1.f / (e0 + e1 + e2);
  e0 *= inv; e1 *= inv; e2 *= inv;
  bf16* cat = (bf16*)(p.ws + OFF_CAT) + ((size_t)(4 + hh) * NT + tokg) * 64 + d0;
  f32x4 va[3][4];
#pragma unroll
  for (int g = 0; g < 3; ++g)
#pragma unroll
    for (int q = 0; q < 4; ++q) va[g][q] = *(const f32x4*)(op[g] + 4 * q);
  __builtin_amdgcn_sched_barrier(0);
  u32x4 o0, o1;
#pragma unroll
  for (int q = 0; q < 4; ++q) {
    const f32x4 a = va[0][q], bb = va[1][q], cc = va[2][q];
    float v0 = e0 * a[0] + e1 * bb[0] + e2 * cc[0], v1 = e0 * a[1] + e1 * bb[1] + e2 * cc[1];
    float v2 = e0 * a[2] + e1 * bb[2] + e2 * cc[2], v3 = e0 * a[3] + e1 * bb[3] + e2 * cc[3];
    if (q < 2) { o0[2 * q] = pack2(v0, v1); o0[2 * q + 1] = pack2(v2, v3); }
    else { o1[2 * (q - 2)] = pack2(v0, v1); o1[2 * (q - 2) + 1] = pack2(v2, v3); }
  }
  *(u32x4*)cat = o0; *(u32x4*)(cat + 8) = o1;
}

__device__ void sb_item(const Params& p, int item, char* smem) {
  const int tid = tid_opaque(), w = tid >> 6, lane = tid & 63, r = lane & 31, half = lane >> 5;
  const int ti = item & 31, h = (item >> 5) % 6, b = item / 192;
  const int t0 = ti * 256, tw = t0 + w * 32, t = tw + r;
  const size_t CH = (size_t)NT * 64;
  const bf16* pb = (const bf16*)(p.ws + OFF_PROJ) + (size_t)b * SEQ * 64;
  const bf16* Kb = pb + (34 + h) * CH;
  const bf16* Vb = pb + (40 + h) * CH;
  int* flags = (int*)(smem + L_SSL);
  s16x8 qf[4];
  load_q(tid, pb + (28 + h) * CH + (size_t)t * 64, qf);
  f32x16 O[2];
#pragma unroll
  for (int dt = 0; dt < 2; ++dt)
#pragma unroll
    for (int i = 0; i < 16; ++i) O[dt][i] = 0.f;
  float Tc = 1.f;
  const int ntiles = (t0 >> 6) + 4;
  int hi = ntiles - 1;
  bool wdone = false;
  for (;;) {
    const int nst = (hi + 1 < 7) ? hi + 1 : 7;
    {
      s16x8 kr[7], vr[7];
#pragma unroll
      for (int j = 0; j < 7; ++j)
        if (j < nst) kv_load(tid, Kb, Vb, 64, (hi - j) * 64, kr[j], vr[j]);
      __syncthreads();
#pragma unroll
      for (int j = 0; j < 7; ++j)
        if (j < nst) kv_store(tid, smem, j, true, kr[j], vr[j]);
    }
    __syncthreads();
#pragma unroll 1
    for (int j = 0; j < nst; ++j) {
      const int k0 = (hi - j) * 64;
      if (!wdone && k0 < tw + 31) {
        const char* kb = smem + j * L_KVB;
        const bool allc = (k0 + 63 < tw);
        f32x16 S[2];
        qk_tile(tid, kb, qf, S);
        float ff[2][16];
#pragma unroll
        for (int kt = 0; kt < 2; ++kt)
#pragma unroll
          for (int i = 0; i < 16; ++i) {
            const float z2 = fmaxf(S[kt][i], -60.f);
            const float e = fexp2(-z2);
            float be = __builtin_amdgcn_rcpf(1.f + e);
            float fv = e * be;
            if (!allc) {
              const int kj = k0 + kt * 32 + (i & 3) + 8 * (i >> 2) + 4 * half;
              const bool causal = kj < t;
              be = causal ? be : 0.f;
              fv = causal ? fv : 1.f;
            }
            ff[kt][i] = fv;
            S[kt][i] = be;
          }
        float Gq[2][4], Go[2][4], P[2][4];
#pragma unroll
        for (int kt = 0; kt < 2; ++kt)
#pragma unroll
          for (int g = 0; g < 4; ++g) {
            Gq[kt][g] = (ff[kt][4 * g] * ff[kt][4 * g + 1]) * (ff[kt][4 * g + 2] * ff[kt][4 * g + 3]);
            Go[kt][g] = __shfl_xor(Gq[kt][g], 32);
            P[kt][g] = Gq[kt][g] * Go[kt][g];
          }
        const float tot1 = (P[1][0] * P[1][1]) * (P[1][2] * P[1][3]);
        const float tot0 = (P[0][0] * P[0][1]) * (P[0][2] * P[0][3]);
        float Sfx[2][4];
        Sfx[1][3] = 1.f; Sfx[1][2] = P[1][3]; Sfx[1][1] = Sfx[1][2] * P[1][2]; Sfx[1][0] = Sfx[1][1] * P[1][1];
        Sfx[0][3] = tot1; Sfx[0][2] = Sfx[0][3] * P[0][3]; Sfx[0][1] = Sfx[0][2] * P[0][2]; Sfx[0][0] = Sfx[0][1] * P[0][1];
#pragma unroll
        for (int kt = 0; kt < 2; ++kt)
#pragma unroll
          for (int g = 0; g < 4; ++g) {
            const float T = Tc * Sfx[kt][g] * (half == 0 ? Go[kt][g] : 1.f);
            const float a3 = T, a2 = a3 * ff[kt][4 * g + 3], a1 = a2 * ff[kt][4 * g + 2], a0 = a1 * ff[kt][4 * g + 1];
            S[kt][4 * g] *= a0;
            S[kt][4 * g + 1] *= a1;
            S[kt][4 * g + 2] *= a2;
            S[kt][4 * g + 3] *= a3;
          }
        Tc *= tot0 * tot1;
        pv_tile(tid, kb + L_VS, S, O);
        wdone = __all(Tc < 1e-36f) != 0;
      }
    }
    hi -= nst;
    if (lane == 0) flags[w] = wdone ? 1 : 0;
    __syncthreads();
    const bool alld = (flags[0] & flags[1] & flags[2] & flags[3] & flags[4] & flags[5] & flags[6] & flags[7]) != 0;
    if (hi < 0 || alld) break;
  }
  bf16* cat = (bf16*)(p.ws + OFF_CAT) + ((size_t)(6 + h) * NT + (size_t)b * SEQ + t) * 64;
#pragma unroll
  for (int dt = 0; dt < 2; ++dt)
#pragma unroll
    for (int g = 0; g < 4; ++g) {
      int d = dt * 32 + 8 * g + 4 * half;
      *(uint2*)(cat + d) = make_uint2(pack2(O[dt][4 * g], O[dt][4 * g + 1]), pack2(O[dt][4 * g + 2], O[dt][4 * g + 3]));
    }
}

#define XB_TMO      128
#define XB_XCNT(j)  (256  + 64 * (j))
#define XB_XSUB(j)  (1280 + 64 * (j))
#define XB_XGEN(j)  (2304 + 64 * (j))
#define XB_TOP      3328
#define XB_TOPGEN   3392
#define XCD_BAR_WORDS 3456
#define XB_SPIN_CAP (1u << 22)
DI unsigned xb_ld(unsigned* p) { return __hip_atomic_load(p, __ATOMIC_RELAXED, __HIP_MEMORY_SCOPE_AGENT); }
DI unsigned xb_add(unsigned* p, unsigned v) { return __hip_atomic_fetch_add(p, v, __ATOMIC_RELAXED, __HIP_MEMORY_SCOPE_AGENT); }
DI unsigned xb_xcc_id() { return (unsigned)__builtin_amdgcn_s_getreg((3 << 11) | 20) & 0xFu; }
#define XB_SPIN(cond, bar) do { unsigned _sp = 0; while (cond) { __builtin_amdgcn_s_sleep(1); \
    if ((++_sp & 255u) == 0u) { if (xb_ld(&(bar)[XB_TMO])) break; if (_sp > XB_SPIN_CAP) { atomicAdd(&(bar)[XB_TMO], 1u); break; } } } } while (0)
struct XcdBarrier { unsigned* bar; unsigned x; volatile LAS unsigned* st; };
DI XcdBarrier xcd_barrier_post(unsigned* bar, volatile LAS unsigned* st) {
  XcdBarrier b; b.bar = bar; b.x = xb_xcc_id(); b.st = st;
  if (threadIdx.x == 0) (void)xb_add(&bar[XB_XCNT(b.x)], 1u);
  return b;
}
DI void xcd_barrier_complete(unsigned* bar, unsigned x, unsigned& nloc, unsigned& nx) {
  const unsigned G = gridDim.x;
  unsigned sum, cnt, mine, sp = 0u;
  for (;;) {
    sum = 0u; cnt = 0u; mine = 0u;
#pragma unroll
    for (unsigned j = 0; j < 16; ++j) { const unsigned c = xb_ld(&bar[XB_XCNT(j)]); sum += c; cnt += (c > 0u) ? 1u : 0u; mine = (j == x) ? c : mine; }
    if (sum == G) break;
    __builtin_amdgcn_s_sleep(1);
    if ((++sp & 255u) == 0u) { if (xb_ld(&bar[XB_TMO])) break; if (sp > XB_SPIN_CAP) { atomicAdd(&bar[XB_TMO], 1u); break; } }
  }
  nloc = mine > 0u ? mine : 1u; nx = cnt > 0u ? cnt : 1u;
}
DI void xcd_barrier(const XcdBarrier& b) {
  asm volatile("s_waitcnt vmcnt(0)" ::: "memory");
  __syncthreads();
  if (threadIdx.x == 0) {
    unsigned* bar = b.bar;
    __builtin_amdgcn_s_waitcnt(0);
    unsigned nloc = b.st[0], nx = b.st[1];
    if (nloc == 0u) { xcd_barrier_complete(bar, b.x, nloc, nx); b.st[0] = nloc; b.st[1] = nx; }
    const unsigned old = xb_add(&bar[XB_XSUB(b.x)], 1u);
    const unsigned gen = old / nloc;
    if (old + 1u == (gen + 1u) * nloc) {
      __builtin_amdgcn_fence(__ATOMIC_RELEASE, "agent");
      asm volatile("s_waitcnt vmcnt(0)" ::: "memory");
      const unsigned og = xb_add(&bar[XB_TOP], 1u);
      const unsigned tg = og / nx;
      if (og + 1u == (tg + 1u) * nx) xb_add(&bar[XB_TOPGEN], 1u);
      else XB_SPIN(xb_ld(&bar[XB_TOPGEN]) == tg, bar);
      __builtin_amdgcn_fence(__ATOMIC_ACQUIRE, "agent");
      xb_add(&bar[XB_XGEN(b.x)], 1u);
      asm volatile("s_waitcnt vmcnt(0)" ::: "memory");
    } else {
      XB_SPIN(xb_ld(&bar[XB_XGEN(b.x)]) == gen, bar);
      __builtin_amdgcn_fence(__ATOMIC_ACQUIRE, "agent");
      asm volatile("s_waitcnt vmcnt(0)" ::: "memory");
    }
  }
  __syncthreads();
}

#define GSYNC() do { for (int rs_ = 0; rs_ < REP_SYNC; ++rs_) xcd_barrier(xb); } while (0)
__global__ void __launch_bounds__(512, 2) fwd_megakernel(Params p) {
  extern __shared__ __attribute__((aligned(16))) char smem[];
  cg::grid_group grid = cg::this_grid();
  const int G = gridDim.x, bid = blockIdx.x;
  if (p.ws == nullptr) grid.sync();
  volatile LAS unsigned* xst = (volatile LAS unsigned*)(smem + L_XB);
  if (threadIdx.x < 4) xst[threadIdx.x] = 0u;
  __syncthreads();
  XcdBarrier xb = xcd_barrier_post((unsigned*)(p.ws + OFF_BAR), xst);

  for (int rep = 0; rep < REP_P0; ++rep) { if (rep) xcd_barrier(xb); phase0(p, smem); }
  GSYNC();

  for (int l = 0; l < 2; ++l) {
    EpiArgs ea;
    ea.layer = l;
    ea.g_nsa = p.g_nsa + l * 256;
    ea.g_dil = p.g_dil + l * 128;
    ea.ssq = (const float*)(p.ws + OFF_SSQ);
    ea.ssq_out = (float*)(p.ws + OFF_SSQ);
    ea.resid = nullptr; ea.outf = nullptr;
    ea.outb = (bf16*)(p.ws + OFF_PROJ);
    for (int rep = 0; rep < REP_P1; ++rep) {
    if (rep) xcd_barrier(xb);
    gemm8<EPI_PROJ>((const bf16*)(p.ws + OFF_XB), (const bf16*)(p.ws + OFF_WIN) + (size_t)l * NP * DM, DM, NP / 256, (NT / 256) * (NP / 256), ea, smem);
    }
    GSYNC();
    for (int rep = 0; rep < REP_P2A; ++rep) {
    if (rep) xcd_barrier(xb);
    for (int it = bid; it < 128 + 384; it += G) {
      if (it < 128) { for (int q = 0; q < REP_CMP; ++q) compress_item(p, l, it, smem); }
      else { for (int q = 0; q < REP_DIL; ++q) dil_item(p, it - 128, smem); }
    }
    }
    GSYNC();
    for (int it = bid; it < 256; it += G) { for (int q = 0; q < REP_NSA; ++q) nsa_item(p, it, smem); }
    {
      unsigned* qcnt = (unsigned*)(p.ws + OFF_QCNT) + l * 64;
      volatile int* qslot = (volatile int*)(smem + L_QS);
      const int nconv = (l == 0) ? WCONV_NCHUNK : 0;
      const int qtotal = 384 + nconv + 256;
      for (;;) {
        __syncthreads();
        if (threadIdx.x == 0) *qslot = (int)atomicAdd(qcnt, 1u);
        __syncthreads();
        const int q = *qslot;
        if (q >= qtotal) break;
        if (q < 384) { for (int q2 = 0; q2 < REP_SB; ++q2) sb_item(p, q, smem); }
        else if (q < 384 + nconv) {
          const int c0 = (q - 384) * WCONV_CHUNK;
          const int c1 = (c0 + WCONV_CHUNK < WCONV_QTILES) ? c0 + WCONV_CHUNK : WCONV_QTILES;
          const int tidq = tid_opaque();
          for (int i = c0 + (tidq >> 7); i < c1; i += 4) {
            int iv = i; asm volatile("" : "+v"(iv));
            const int li = (iv < WCONV_L0Q) ? 0 : 1;
            const TrDesc d = wconv_desc(p, li, li ? iv - WCONV_L0Q : iv + 768);
            tr_direct(d, tidq & 127);
          }
        } else dilc_item(p, q - 384 - nconv);
      }
    }
    GSYNC();
    ea.outb = (bf16*)(p.ws + OFF_XB);
    ea.resid = nullptr;
    ea.outf = nullptr;
    gemm8<EPI_RES>((const bf16*)(p.ws + OFF_CAT), (const bf16*)(p.ws + OFF_WOUT) + (size_t)l * DM * DCAT, DCAT, DM / 256, (NT / 256) * (DM / 256), ea, smem);
    GSYNC();
    ea.outb = (bf16*)(p.ws + OFF_U);
    for (int rep = 0; rep < REP_P3B; ++rep) {
    if (rep) xcd_barrier(xb);
    gemm8<EPI_UP>((const bf16*)(p.ws + OFF_XB), (const bf16*)(p.ws + OFF_WUP) + (size_t)l * DFF * DM, DM, DFF / 256, (NT / 256) * (DFF / 256), ea, smem);
    }
    GSYNC();
    ea.outb = (bf16*)(p.ws + OFF_XB);
    ea.resid = nullptr;
    ea.outf = (l == 1) ? p.out : nullptr;
    gemm8<EPI_RES>((const bf16*)(p.ws + OFF_U), (const bf16*)(p.ws + OFF_WDN) + (size_t)l * DM * DFF, DFF, DM / 256, (NT / 256) * (DM / 256), ea, smem);
    if (l == 0) GSYNC();
  }
}

extern "C" void kernel_launch(void* const* d_in, const int* in_sizes, int n_in, void* d_out, int out_size, void* d_ws, size_t ws_size,
                              hipStream_t stream) {
  static int grid_blocks = 0;
  if (!grid_blocks) {
    int dev = 0, cus = 0, per_cu = 0;
    hipGetDevice(&dev);
    hipDeviceGetAttribute(&cus, hipDeviceAttributeMultiprocessorCount, dev);
    hipFuncSetAttribute((const void*)fwd_megakernel, hipFuncAttributeMaxDynamicSharedMemorySize, LDS_BYTES);
    hipOccupancyMaxActiveBlocksPerMultiprocessor(&per_cu, (const void*)fwd_megakernel, NTHR, LDS_BYTES);
    per_cu = 1;
    grid_blocks = cus * per_cu;
    if (ws_size < WS_NEED) fprintf(stderr, "workspace too small: %zu < %zu\n", ws_size, (size_t)WS_NEED);
  }
  Params p{};
  p.x = (const float*)d_in[0]; p.norm_mix = (const float*)d_in[1]; p.norm_mlp = (const float*)d_in[2];
  p.w_in = (const float*)d_in[3]; p.g_nsa = (const float*)d_in[4]; p.g_dil = (const float*)d_in[5];
  p.pe = (const float*)d_in[6]; p.w1 = (const float*)d_in[7]; p.w2 = (const float*)d_in[8];
  p.w_out = (const float*)d_in[9]; p.w_up = (const float*)d_in[10]; p.w_down = (const float*)d_in[11];
  p.out = (float*)d_out; p.ws = (unsigned char*)d_ws;
  hipMemsetAsync((char*)d_ws + OFF_BAR, 0, 16384, stream);
  void* args[] = {&p};
  hipError_t e = hipLaunchCooperativeKernel((const void*)fwd_megakernel, dim3(grid_blocks), dim3(NTHR), args, LDS_BYTES, stream);
  if (e != hipSuccess) fprintf(stderr, "cooperative launch failed: %s (grid %d)\n", hipGetErrorString(e), grid_blocks);
}
```

```cpp
#include <hip/hip_runtime.h>
#include <hip/hip_cooperative_groups.h>
#include <stdint.h>
#include <stdio.h>
namespace cg = cooperative_groups;
#ifndef REP_P0
#define REP_P0 1
#endif
#ifndef REP_SYNC
#define REP_SYNC 1
#endif
#ifndef REP_CMP
#define REP_CMP 1
#endif
#ifndef REP_SB
#define REP_SB 1
#endif
#ifndef REP_DIL
#define REP_DIL 1
#endif
#ifndef REP_NSA
#define REP_NSA 1
#endif
#ifndef REP_SEL
#define REP_SEL 1
#endif
#ifndef REP_WIN
#define REP_WIN 1
#endif
#ifndef REP_CMPA
#define REP_CMPA 1
#endif
#ifndef REP_EPI
#define REP_EPI 1
#endif
#ifndef REP_P1
#define REP_P1 1
#endif
#ifndef REP_P2A
#define REP_P2A 1
#endif
#ifndef REP_P2B
#define REP_P2B 1
#endif
#ifndef REP_P3B
#define REP_P3B 1
#endif

typedef unsigned short bf16;
typedef short s16x8 __attribute__((ext_vector_type(8)));
typedef short s16x4 __attribute__((ext_vector_type(4)));
typedef float f32x4 __attribute__((ext_vector_type(4)));
typedef float f32x16 __attribute__((ext_vector_type(16)));
typedef unsigned u32x4 __attribute__((ext_vector_type(4)));

#define DI __device__ __forceinline__
#define MFMA16(a, b, c) __builtin_amdgcn_mfma_f32_16x16x32_bf16((a), (b), (c), 0, 0, 0)
#define MFMA32(a, b, c) __builtin_amdgcn_mfma_f32_32x32x16_bf16((a), (b), (c), 0, 0, 0)

constexpr int DM = 1024, SEQ = 8192, NB = 2, NT = NB * SEQ, NP = 3072, DCAT = 768, DFF = 4096;
constexpr float LOG2E = 1.4426950408889634f;
constexpr float EPS = 1e-6f;
constexpr float NEGB = -1e30f;

constexpr size_t OFF_WIN = 0;
constexpr size_t OFF_WOUT = 12582912;
constexpr size_t OFF_WUP = 15728640;
constexpr size_t OFF_WDN = 32505856;
constexpr size_t OFF_W1T = 49283072;
constexpr size_t OFF_W2T = 51380224;
constexpr size_t OFF_XB = 51445760;
constexpr size_t OFF_SSQ = 85000192;
constexpr size_t OFF_KC = 85524480;
constexpr size_t OFF_VC = 85655552;
constexpr size_t OFF_PROJ = 85786624;
constexpr size_t OFF_DILO = 186449920;
constexpr size_t OFF_DILL = 211615744;
constexpr size_t OFF_CAT = 212008960;
constexpr size_t OFF_U = OFF_PROJ;
constexpr size_t OFF_BAR = 237174784;
constexpr size_t OFF_QCNT = OFF_BAR + 14336;
constexpr size_t WS_NEED = 237174784 + 16384;

constexpr int NTHR = 512;
constexpr int LDS_BYTES = 131072 + 8192;
constexpr int L_SSL = 131072;
constexpr int L_XB = 131072 + 4096;
constexpr int L_QS = 131072 + 4096 + 64;
constexpr int L_VS = 9216, L_KVB = 18432, L_IMP = 36864, L_IMPE = 70656, L_SELM = 104448, L_LIST = 105472, L_FLAG = 106000;
constexpr int KROW = 144;
constexpr int IMPW = 132;

struct Params {
  const float *x, *norm_mix, *norm_mlp, *w_in, *g_nsa, *g_dil, *pe, *w1, *w2, *w_out, *w_up, *w_down;
  float* out;
  unsigned char* ws;
};

DI unsigned short f2bf(float x) { unsigned u = __float_as_uint(x); u += 0x7fffu + ((u >> 16) & 1u); return (unsigned short)(u >> 16); }
DI float bf2f(unsigned short b) { return __uint_as_float(((unsigned)b) << 16); }
typedef __bf16 bf16x2v __attribute__((ext_vector_type(2)));
DI unsigned pack2(float a, float b) { bf16x2v v; v[0] = (__bf16)a; v[1] = (__bf16)b; return __builtin_bit_cast(unsigned, v); }
DI int tid_opaque() { int t = threadIdx.x; asm volatile("" : "+v"(t)); return t; }
DI size_t blk(int nrows, int row, int col) { return ((size_t)(col >> 6) * nrows + row) * 64 + (col & 63); }
DI int crow(int i, int half) { return (i & 3) + 8 * (i >> 2) + 4 * half; }

struct TrDesc { const float* src; int srcN, srcCol0, nvalid, k0; bf16* dst; int dstK, n0; const float* gain; int perm, dstN; };
struct TrRegs { f32x4 v[2]; float g[2]; };

DI void tr_load(const TrDesc& d, int tid, TrRegs& r) {
#pragma unroll
  for (int i = 0; i < 2; ++i) {
    const int idx = tid + i * 512, kk = idx >> 4, nn = (idx & 15) * 4;
    r.v[i] = f32x4{0.f, 0.f, 0.f, 0.f}; r.g[i] = 1.f;
    if (nn < d.nvalid) {
      r.v[i] = *(const f32x4*)(d.src + (size_t)(d.k0 + kk) * d.srcN + d.srcCol0 + nn);
      if (d.gain) r.g[i] = d.gain[d.k0 + kk];
    }
  }
}
DI void tr_finish(const TrDesc& d, int tid, const TrRegs& r, float* lds) {
  __syncthreads();
#pragma unroll
  for (int i = 0; i < 2; ++i) {
    const int idx = tid + i * 512, kk = idx >> 4, nn = (idx & 15) * 4;
    const float g = r.g[i];
    lds[kk * 65 + nn] = r.v[i][0] * g; lds[kk * 65 + nn + 1] = r.v[i][1] * g; lds[kk * 65 + nn + 2] = r.v[i][2] * g; lds[kk * 65 + nn + 3] = r.v[i][3] * g;
  }
  __syncthreads();
  {
    int n = tid >> 3, kc = (tid & 7) * 8;
    u32x4 o;
    o[0] = pack2(lds[(kc + 0) * 65 + n], lds[(kc + 1) * 65 + n]);
    o[1] = pack2(lds[(kc + 2) * 65 + n], lds[(kc + 3) * 65 + n]);
    o[2] = pack2(lds[(kc + 4) * 65 + n], lds[(kc + 5) * 65 + n]);
    o[3] = pack2(lds[(kc + 6) * 65 + n], lds[(kc + 7) * 65 + n]);
    const int xg = n & 31, xp = d.dstN ? (((xg >> 2) & 1) * 16 + (xg >> 3) * 4 + (xg & 3)) : xg;
    int drow = d.n0 + (n & 32) + xp;
    if (d.perm) {
      int tb = d.n0 & ~255, wc = (d.n0 >> 6) & 3;
      drow = tb + (n >> 5) * 128 + wc * 32 + xp;
    }
    if (d.dstN) *(u32x4*)(d.dst + ((size_t)(d.k0 >> 6) * d.dstN + drow) * 64 + kc) = o;
    else *(u32x4*)(d.dst + (size_t)drow * d.dstK + d.k0 + kc) = o;
  }
}

DI TrDesc wconv_desc(const Params& p, int l, int q) {
  TrDesc d;
  if (q < 768) {
    int nc = q / 16, kt = q % 16, n0 = nc * 64;
    int src0, nvalid;
    if (n0 < 640) { src0 = n0; nvalid = 64; }
    else if (n0 < 2944) { src0 = n0 + 12; nvalid = 64; }
    else if (n0 == 2944) { src0 = 640; nvalid = 12; }
    else { src0 = 0; nvalid = 0; }
    d = TrDesc{p.w_in + (size_t)l * 1024 * 2956, 2956, src0, nvalid, kt * 64, (bf16*)(p.ws + OFF_WIN) + (size_t)l * 3072 * 1024, 1024, n0, p.norm_mix + l * 1024, 1, 3072};
  } else if (q < 960) {
    int qq = q - 768, nc = qq / 12, kt = qq % 12;
    d = TrDesc{p.w_out + (size_t)l * 768 * 1024, 1024, nc * 64, 64, kt * 64, (bf16*)(p.ws + OFF_WOUT) + (size_t)l * 1024 * 768, 768, nc * 64, nullptr, 0, 1024};
  } else if (q < 1984) {
    int qq = q - 960, nc = qq / 16, kt = qq % 16;
    d = TrDesc{p.w_up + (size_t)l * 1024 * 4096, 4096, nc * 64, 64, kt * 64, (bf16*)(p.ws + OFF_WUP) + (size_t)l * 4096 * 1024, 1024, nc * 64, p.norm_mlp + l * 1024, 0, 4096};
  } else if (q < 3008) {
    int qq = q - 1984, nc = qq / 64, kt = qq % 64;
    d = TrDesc{p.w_down + (size_t)l * 4096 * 1024, 1024, nc * 64, 64, kt * 64, (bf16*)(p.ws + OFF_WDN) + (size_t)l * 1024 * 4096, 4096, nc * 64, nullptr, 0, 1024};
  } else if (q < 3136) {
    int qq = q - 3008, c = qq / 64, r2 = qq % 64, nc = r2 / 32, kt = r2 % 32;
    d = TrDesc{p.w1 + ((size_t)l * 2 + c) * 2048 * 128, 128, nc * 64, 64, kt * 64, (bf16*)(p.ws + OFF_W1T) + ((size_t)l * 2 + c) * 128 * 2048, 2048, nc * 64, nullptr, 0, 0};
  } else {
    int qq = q - 3136, c = qq / 2, kt = qq % 2;
    d = TrDesc{p.w2 + ((size_t)l * 2 + c) * 128 * 64, 64, 0, 64, kt * 64, (bf16*)(p.ws + OFF_W2T) + ((size_t)l * 2 + c) * 64 * 128, 128, 0, nullptr, 0, 0};
  }
  return d;
}
DI void tr_direct(const TrDesc& d, int t) {
  const int kgrp = t >> 4, nn = (t & 15) * 4, kc = kgrp * 8;
  f32x4 v[8];
  f32x4 g0 = f32x4{1.f, 1.f, 1.f, 1.f}, g1 = g0;
#pragma unroll
  for (int j = 0; j < 8; ++j) v[j] = f32x4{0.f, 0.f, 0.f, 0.f};
  if (nn < d.nvalid) {
#pragma unroll
    for (int j = 0; j < 8; ++j) v[j] = *(const f32x4*)(d.src + (size_t)(d.k0 + kc + j) * d.srcN + d.srcCol0 + nn);
    if (d.gain) { g0 = *(const f32x4*)(d.gain + d.k0 + kc); g1 = *(const f32x4*)(d.gain + d.k0 + kc + 4); }
  }
  __builtin_amdgcn_sched_barrier(0);
#pragma unroll
  for (int c = 0; c < 4; ++c) {
    u32x4 o;
    o[0] = pack2(v[0][c] * g0[0], v[1][c] * g0[1]); o[1] = pack2(v[2][c] * g0[2], v[3][c] * g0[3]);
    o[2] = pack2(v[4][c] * g1[0], v[5][c] * g1[1]); o[3] = pack2(v[6][c] * g1[2], v[7][c] * g1[3]);
    const int n = nn + c;
    const int xg = n & 31, xp = d.dstN ? (((xg >> 2) & 1) * 16 + (xg >> 3) * 4 + (xg & 3)) : xg;
    int drow = d.n0 + (n & 32) + xp;
    if (d.perm) {
      int tb = d.n0 & ~255, wc = (d.n0 >> 6) & 3;
      drow = tb + (n >> 5) * 128 + wc * 32 + xp;
    }
    if (d.dstN) *(u32x4*)(d.dst + ((size_t)(d.k0 >> 6) * d.dstN + drow) * 64 + kc) = o;
    else *(u32x4*)(d.dst + (size_t)drow * d.dstK + d.k0 + kc) = o;
  }
}
DI void wconv_run(const Params& p, int l, int first, int last, int stride, float* lds) {
  const int tid = tid_opaque();
  const int tq = tid >> 7, t = tid & 127;
  for (int q = first + tq * stride; q < last; q += 4 * stride) {
    int qv = q; asm volatile("" : "+v"(qv));
    const TrDesc d = wconv_desc(p, l, qv);
    tr_direct(d, t);
  }
}
DI void wconv_run_lds(const Params& p, int l, int first, int last, int stride, float* lds) {
  const int tid = tid_opaque();
  if (first >= last) return;
  TrDesc d = wconv_desc(p, l, first); TrRegs r;
  tr_load(d, tid, r);
  for (int q = first; q < last; q += stride) {
    TrDesc dn = d; TrRegs rn = r;
    const bool more = (q + stride < last);
    if (more) { dn = wconv_desc(p, l, q + stride); tr_load(dn, tid, rn); }
    tr_finish(d, tid, r, lds);
    d = dn; r = rn;
  }
}
constexpr int WCONV_TILES = 768 + 192 + 1024 + 1024 + 128 + 4;
constexpr int WCONV_CHUNK = 16;
constexpr int WCONV_L0Q = 3008 - 768;
constexpr int WCONV_QTILES = WCONV_L0Q + WCONV_TILES;
constexpr int WCONV_NCHUNK = (WCONV_QTILES + WCONV_CHUNK - 1) / WCONV_CHUNK;

__device__ void phase0(const Params& p, char* smem) {
  float* lds = (float*)smem;
  const int NTR = WCONV_TILES;
  const int NX = NT / 8;
  wconv_run_lds(p, 0, blockIdx.x, 768, gridDim.x, lds);
  wconv_run_lds(p, 0, 3008 + blockIdx.x, WCONV_TILES, gridDim.x, lds);
  for (int it = blockIdx.x; it < NX; it += gridDim.x) {
    const int tid0 = tid_opaque();
    int row = it * 8 + (tid0 >> 6), lane = tid0 & 63;
    const float* xr = p.x + (size_t)row * DM;
    bf16* xb = (bf16*)(p.ws + OFF_XB);
    f32x4 xv[4];
#pragma unroll
    for (int i = 0; i < 2; ++i) { xv[2 * i] = *(const f32x4*)(xr + i * 512 + lane * 8); xv[2 * i + 1] = *(const f32x4*)(xr + i * 512 + lane * 8 + 4); }
    __builtin_amdgcn_sched_barrier(0);
    float ss = 0.f;
#pragma unroll
    for (int i = 0; i < 2; ++i) {
      const f32x4 v = xv[2 * i], w4 = xv[2 * i + 1];
      ss += (v[0] * v[0] + v[1] * v[1] + v[2] * v[2] + v[3] * v[3]) + (w4[0] * w4[0] + w4[1] * w4[1] + w4[2] * w4[2] + w4[3] * w4[3]);
      u32x4 o;
      o[0] = pack2(v[0], v[1]); o[1] = pack2(v[2], v[3]); o[2] = pack2(w4[0], w4[1]); o[3] = pack2(w4[2], w4[3]);
      *(u32x4*)(xb + blk(NT, row, i * 512 + lane * 8)) = o;
    }
    for (int o = 32; o > 0; o >>= 1) ss += __shfl_xor(ss, o);
    float* sq = (float*)(p.ws + OFF_SSQ) + (size_t)row * 8;
    if (lane < 8) sq[lane] = (lane == 0) ? ss : 0.f;
  }
}

DI int lds_byte(int r, int c) {
  int st = (r >> 4) * 2 + (c >> 5), rr = r & 15, cc = c & 31, ob = rr * 64 + cc * 2;
  return st * 1024 + (ob ^ (((ob >> 9) & 1) << 5));
}
DI void stage_rc(int b, int& R, int& C) {
  int st = b / 1024, sb = b % 1024, swz = sb ^ (((sb >> 9) & 1) << 5);
  R = (st >> 1) * 16 + swz / 64; C = (st & 1) * 32 + (swz % 64) / 2;
}
enum { EPI_PROJ = 0, EPI_RES = 1, EPI_UP = 2 };

struct EpiArgs {
  int layer;
  const float* g_nsa;
  const float* g_dil;
  const float* ssq;
  bf16* outb;
  const float* resid;
  float* outf;
  float* ssq_out;
};

#define LAS __attribute__((address_space(3)))
#define WAIT_V(n) asm volatile("s_waitcnt vmcnt(" #n ")" ::: "memory")
#define WAIT_L(n) asm volatile("s_waitcnt lgkmcnt(" #n ")" ::: "memory")
#define BAR __builtin_amdgcn_s_barrier()
#define SCHED __builtin_amdgcn_sched_barrier(0)

DI uint2 pack4(float a, float b, float c, float d) { return make_uint2(pack2(a, b), pack2(c, d)); }

template <int EPI>
__device__ void gemm8(const bf16* A, const bf16* Bt, const int K, const int ntN, const int ntTot, const EpiArgs ea, char* smem) {
  const int tid = tid_opaque(), wid = tid >> 6, lane = tid & 63, wr = wid >> 2, wc = wid & 3, fr = lane & 15, fq = lane >> 4;
  int R0, C0;
  stage_rc(tid * 16, R0, C0);
  const unsigned goffb = (unsigned)(R0 * 64 + C0) * 2u;
  const size_t ssA = (size_t)NT * 128, ssB = (size_t)ntN * 256 * 128;
  const int ldst = __builtin_amdgcn_readfirstlane(tid * 16);
  const int a_rd = lds_byte(wr * 64 + fr, fq * 8), b_rd = 65536 + lds_byte(wc * 32 + fr, fq * 8);
  const int nt = K / 64;
  const int G = gridDim.x;
  const int vb = (blockIdx.x & 7) * (G >> 3) + (blockIdx.x >> 3);
  float* ssl = (float*)(smem + L_SSL);
#define SA(b, h) (smem + ((b) * 2 + (h)) * 16384)
#define SB(b, h) (smem + (4 + (b) * 2 + (h)) * 16384)
#define STAGE(P, BASE, kt) do { const char* _s = (const char*)(BASE) + (size_t)(kt) * SS_; char* _d = (P) + ldst; \
    __builtin_amdgcn_global_load_lds((const unsigned*)(_s + goffb), (LAS unsigned*)_d, 16, 0, 0); \
    __builtin_amdgcn_global_load_lds((const unsigned*)(_s + 8192 + goffb), (LAS unsigned*)(_d + 8192), 16, 0, 0); } while (0)
#define STAGEA(P, BASE, kt) do { const size_t SS_ = ssA; STAGE(P, BASE, kt); } while (0)
#define STAGEB(P, BASE, kt) do { const size_t SS_ = ssB; STAGE(P, BASE, kt); } while (0)
#define LDA(dst, b, h) _Pragma("unroll") for (int m = 0; m < 4; ++m) _Pragma("unroll") for (int k = 0; k < 2; ++k) \
    dst[m][k] = *(const s16x8*)(smem + a_rdo + ((b) * 2 + (h)) * 16384 + m * 2048 + k * 1024)
#define LDB(dst, b, h) _Pragma("unroll") for (int n = 0; n < 2; ++n) _Pragma("unroll") for (int k = 0; k < 2; ++k) \
    dst[n][k] = *(const s16x8*)(smem + b_rdo + ((b) * 2 + (h)) * 16384 + n * 2048 + k * 1024)
#define MMA(ai, bj, Ax, Bx) do { __builtin_amdgcn_s_setprio(1); \
    _Pragma("unroll") for (int m = 0; m < 4; ++m) _Pragma("unroll") for (int n = 0; n < 2; ++n) _Pragma("unroll") for (int k = 0; k < 2; ++k) \
      acc[ai][bj][m][n] = MFMA16(Bx[n][k], Ax[m][k], acc[ai][bj][m][n]); \
    __builtin_amdgcn_s_setprio(0); } while (0)

  for (int tile = vb; tile < ntTot; tile += G) {
    const int tn = tile % ntN, tm = tile / ntN;
    const int brow = tm * 256, bcol = tn * 256;
    const bf16* A0 = A + (size_t)brow * 64;
    const bf16* A1 = A0 + (size_t)128 * 64;
    const bf16* B0g = Bt + (size_t)bcol * 64;
    const bf16* B1g = B0g + (size_t)128 * 64;
    f32x4 acc[2][2][4][2];
#pragma unroll
    for (int a = 0; a < 2; ++a)
#pragma unroll
      for (int b = 0; b < 2; ++b)
#pragma unroll
        for (int m = 0; m < 4; ++m)
#pragma unroll
          for (int n = 0; n < 2; ++n) acc[a][b][m][n] = f32x4{0.f, 0.f, 0.f, 0.f};
    s16x8 At[4][2], B0[2][2], B1[2][2];
    __syncthreads();
    if (EPI != EPI_RES) {
      if (tid < 256) {
        const float* sq = ea.ssq + (size_t)(brow + tid) * 8;
        const f32x4 q0 = *(const f32x4*)sq, q1 = *(const f32x4*)(sq + 4);
        ssl[tid] = rsqrtf((((q0[0] + q0[1]) + (q0[2] + q0[3])) + ((q1[0] + q1[1]) + (q1[2] + q1[3]))) * (1.f / 1024.f) + EPS);
      }
    }
    STAGEB(SB(0, 0), B0g, 0); STAGEA(SA(0, 0), A0, 0);
    STAGEB(SB(0, 1), B1g, 0); STAGEA(SA(0, 1), A1, 0);
    if (wr == 1) BAR;
    WAIT_V(4); BAR;
    STAGEB(SB(1, 0), B0g, 1); STAGEA(SA(1, 0), A0, 1); STAGEB(SB(1, 1), B1g, 1);
    WAIT_V(6); BAR;
    int a_rdo = a_rd, b_rdo = b_rd;
    for (int t = 0; t < nt - 2; t += 2) {
      asm volatile("" : "+v"(a_rdo), "+v"(b_rdo));
      LDB(B0, 0, 0); SCHED; LDA(At, 0, 0); STAGEA(SA(1, 1), A1, t + 1);
      WAIT_L(8); BAR; WAIT_L(0); MMA(0, 0, At, B0); BAR; SCHED;
      LDB(B1, 0, 1); STAGEB(SB(0, 0), B0g, t + 2);
      BAR; WAIT_L(0); MMA(0, 1, At, B1); BAR;
      LDA(At, 0, 1); STAGEA(SA(0, 0), A0, t + 2);
      BAR; WAIT_L(0); MMA(1, 0, At, B0); BAR; SCHED;
      STAGEB(SB(0, 1), B1g, t + 2);
      WAIT_V(6); BAR; MMA(1, 1, At, B1); BAR;
      LDB(B0, 1, 0); SCHED; LDA(At, 1, 0); STAGEA(SA(0, 1), A1, t + 2);
      WAIT_L(8); BAR; WAIT_L(0); MMA(0, 0, At, B0); BAR; SCHED;
      LDB(B1, 1, 1); STAGEB(SB(1, 0), B0g, t + 3);
      BAR; WAIT_L(0); MMA(0, 1, At, B1); BAR;
      LDA(At, 1, 1); STAGEA(SA(1, 0), A0, t + 3);
      BAR; WAIT_L(0); MMA(1, 0, At, B0); BAR; SCHED;
      STAGEB(SB(1, 1), B1g, t + 3);
      WAIT_V(6); BAR; MMA(1, 1, At, B1); BAR;
    }
    asm volatile("" : "+v"(a_rdo), "+v"(b_rdo));
    { LDB(B0, 0, 0); LDA(At, 0, 0); STAGEA(SA(1, 1), A1, nt - 1);
      BAR; WAIT_L(0); MMA(0, 0, At, B0); BAR;
      LDB(B1, 0, 1); BAR; WAIT_L(0); MMA(0, 1, At, B1); BAR;
      LDA(At, 0, 1); WAIT_V(4); BAR; WAIT_L(0); MMA(1, 0, At, B0); MMA(1, 1, At, B1); BAR; }
    { LDB(B0, 1, 0); LDA(At, 1, 0); WAIT_V(2); BAR; WAIT_L(0); MMA(0, 0, At, B0); BAR;
      LDB(B1, 1, 1); WAIT_V(0); BAR; WAIT_L(0); MMA(0, 1, At, B1); BAR;
      LDA(At, 1, 1); BAR; WAIT_L(0); MMA(1, 0, At, B0); MMA(1, 1, At, B1); BAR; }
    if (wr == 0) BAR;
    for (int re = 0; re < ((EPI == EPI_RES) ? 1 : REP_EPI); ++re) {
    if (EPI == EPI_PROJ) {
      const int c = tn * 4 + wc;
      int nsel = 0; const float* gp = ea.g_nsa; float qs = 1.f;
      if (c < 4) { nsel = 1; gp = ea.g_nsa; qs = 0.125f * LOG2E; }
      else if (c == 6) { nsel = 1; gp = ea.g_nsa + 128; }
      else if (c == 8) { nsel = 1; gp = ea.g_nsa + 192; }
      else if (c >= 10 && c < 16) { nsel = 1; gp = ea.g_dil; qs = 0.125f * LOG2E; }
      else if (c >= 16 && c < 22) { nsel = 1; gp = ea.g_dil + 64; }
      else if (c >= 28 && c < 34) { qs = 0.125f * LOG2E; }
      const bool dperm = (c >= 10 && c < 28);
      const int sh = dperm ? ((((c - 10) % 6) >> 1) * 2) : 0;
      float gv[2][2][4];
#pragma unroll
      for (int bj = 0; bj < 2; ++bj)
#pragma unroll
        for (int n = 0; n < 2; ++n) {
          f32x4 g4 = *(const f32x4*)(gp + bj * 32 + fq * 8 + n * 4);
#pragma unroll
          for (int j = 0; j < 4; ++j) gv[bj][n][j] = nsel ? g4[j] * qs : qs;
        }
#pragma unroll
      for (int ai = 0; ai < 2; ++ai)
#pragma unroll
        for (int m = 0; m < 4; ++m) {
          const int row = brow + ai * 128 + wr * 64 + m * 16 + fr;
          const float rs = ssl[ai * 128 + wr * 64 + m * 16 + fr];
          float v[2][2][4]; float ss = 0.f;
#pragma unroll
          for (int bj = 0; bj < 2; ++bj)
#pragma unroll
            for (int n = 0; n < 2; ++n)
#pragma unroll
              for (int j = 0; j < 4; ++j) { float x = acc[ai][bj][m][n][j] * rs; v[bj][n][j] = x; ss += x * x; }
          float rr = 1.f;
          if (nsel) {
            ss += __shfl_xor(ss, 16); ss += __shfl_xor(ss, 32);
            rr = rsqrtf(ss * (1.f / 64.f) + EPS);
          }
          int grow = row;
          if (dperm) {
            int b = row >> 13, t = row & (SEQ - 1);
            grow = b * SEQ + (t & ((1 << sh) - 1)) * (SEQ >> sh) + (t >> sh);
          }
          bf16* orow = ea.outb + ((size_t)c * NT + grow) * 64 + fq * 8;
#pragma unroll
          for (int bj = 0; bj < 2; ++bj) {
            u32x4 o;
            o[0] = pack2(v[bj][0][0] * rr * gv[bj][0][0], v[bj][0][1] * rr * gv[bj][0][1]);
            o[1] = pack2(v[bj][0][2] * rr * gv[bj][0][2], v[bj][0][3] * rr * gv[bj][0][3]);
            o[2] = pack2(v[bj][1][0] * rr * gv[bj][1][0], v[bj][1][1] * rr * gv[bj][1][1]);
            o[3] = pack2(v[bj][1][2] * rr * gv[bj][1][2], v[bj][1][3] * rr * gv[bj][1][3]);
            *(u32x4*)(orow + bj * 32) = o;
          }
        }
    } else if (EPI == EPI_UP) {
#pragma unroll
      for (int ai = 0; ai < 2; ++ai)
#pragma unroll
        for (int m = 0; m < 4; ++m) {
          const int row = brow + ai * 128 + wr * 64 + m * 16 + fr;
          const float rs = ssl[ai * 128 + wr * 64 + m * 16 + fr];
          bf16* orow = ea.outb + blk(NT, row, bcol + wc * 32 + fq * 8);
#pragma unroll
          for (int bj = 0; bj < 2; ++bj) {
            u32x4 o;
#pragma unroll
            for (int n = 0; n < 2; ++n) {
              float x0 = fmaxf(acc[ai][bj][m][n][0] * rs, 0.f), x1 = fmaxf(acc[ai][bj][m][n][1] * rs, 0.f);
              float x2 = fmaxf(acc[ai][bj][m][n][2] * rs, 0.f), x3 = fmaxf(acc[ai][bj][m][n][3] * rs, 0.f);
              o[2 * n] = pack2(x0 * x0, x1 * x1); o[2 * n + 1] = pack2(x2 * x2, x3 * x3);
            }
            *(u32x4*)(orow + (size_t)bj * 2 * NT * 64) = o;
          }
        }
    } else {
      const bool of32 = (ea.outf != nullptr);
      u32x4 ru[2][4][2];
#pragma unroll
      for (int ai = 0; ai < 2; ++ai)
#pragma unroll
        for (int m = 0; m < 4; ++m)
#pragma unroll
          for (int bj = 0; bj < 2; ++bj)
            ru[ai][m][bj] = *(const u32x4*)(ea.outb + blk(NT, brow + ai * 128 + wr * 64 + m * 16 + fr, bcol + wc * 32 + bj * 128 + fq * 8));
      __builtin_amdgcn_sched_barrier(0);
#pragma unroll
      for (int ai = 0; ai < 2; ++ai) {
#pragma unroll
        for (int m = 0; m < 4; ++m) {
          const int lr = ai * 128 + wr * 64 + m * 16 + fr;
          float ss = 0.f;
#pragma unroll
          for (int bj = 0; bj < 2; ++bj) {
            const int col = bcol + wc * 32 + bj * 128 + fq * 8;
            const u32x4 u = ru[ai][m][bj];
            const f32x4 r0 = f32x4{__uint_as_float(u[0] << 16), __uint_as_float(u[0] & 0xffff0000u), __uint_as_float(u[1] << 16), __uint_as_float(u[1] & 0xffff0000u)};
            const f32x4 r1 = f32x4{__uint_as_float(u[2] << 16), __uint_as_float(u[2] & 0xffff0000u), __uint_as_float(u[3] << 16), __uint_as_float(u[3] & 0xffff0000u)};
            const f32x4 v0 = acc[ai][bj][m][0] + r0, v1 = acc[ai][bj][m][1] + r1;
            if (of32) {
              float* op = ea.outf + (size_t)(brow + lr) * DM + col;
              *(f32x4*)op = v0; *(f32x4*)(op + 4) = v1;
            } else {
              u32x4 o;
              o[0] = pack2(v0[0], v0[1]); o[1] = pack2(v0[2], v0[3]); o[2] = pack2(v1[0], v1[1]); o[3] = pack2(v1[2], v1[3]);
              *(u32x4*)(ea.outb + blk(NT, brow + lr, col)) = o;
            }
            ss += ((v0[0] * v0[0] + v0[1] * v0[1]) + (v0[2] * v0[2] + v0[3] * v0[3])) + ((v1[0] * v1[0] + v1[1] * v1[1]) + (v1[2] * v1[2] + v1[3] * v1[3]));
          }
          ss += __shfl_xor(ss, 16); ss += __shfl_xor(ss, 32);
          if (fq == 0) ssl[wc * 256 + lr] = ss;
        }
      }
      __syncthreads();
      if (tid < 256) ea.ssq_out[(size_t)(brow + tid) * 8 + tn] = (ssl[tid] + ssl[256 + tid]) + (ssl[512 + tid] + ssl[768 + tid]);
    }
    }
  }
}

DI float gelu_tanh(float x) {
  float u = 0.7978845608028654f * (x + 0.044715f * x * x * x);
  float e = __expf(2.f * u);
  float th = 1.f - 2.f / (e + 1.f);
  return 0.5f * x * (1.f + th);
}

__device__ void compress_item(const Params& p, int l, int item, char* smem) {
  const int tid = tid_opaque(), w = tid >> 6, lane = tid & 63, fr = lane & 15, fq = lane >> 4;
  const int b = item >> 6, c = (item >> 5) & 1, nt = item & 31;
  const bf16* proj = (const bf16*)(p.ws + OFF_PROJ);
  const bf16* w1t = (const bf16*)(p.ws + OFF_W1T) + ((size_t)l * 2 + c) * 128 * 2048;
  const bf16* w2t = (const bf16*)(p.ws + OFF_W2T) + ((size_t)l * 2 + c) * 64 * 128;
  const float* pe = p.pe + ((size_t)l * 2 + c) * 32 * 64;
  float* part = (float*)smem;
  bf16* hid = (bf16*)(smem + 8 * 16 * 132 * 4);
  float* outf = (float*)(smem + 8 * 16 * 132 * 4 + 16 * 136 * 2);
  __syncthreads();
  const int n = nt * 16 + fr;
  f32x4 acc[8];
#pragma unroll
  for (int q = 0; q < 8; ++q) acc[q] = f32x4{0.f, 0.f, 0.f, 0.f};
#pragma unroll
  for (int kp = 0; kp < 4; ++kp) {
    s16x8 a8[2], b8[2][8]; f32x4 p0[2], p1[2];
#pragma unroll
    for (int u = 0; u < 2; ++u) {
      const int ks = w * 8 + kp * 2 + u;
      int tok = 16 * n + (ks >> 1); if (tok > SEQ - 1) tok = SEQ - 1;
      const int d0 = (ks & 1) * 32 + fq * 8;
      a8[u] = *(const s16x8*)(proj + ((size_t)(4 + c) * NT + (size_t)b * SEQ + tok) * 64 + d0);
      const float* pp = pe + (ks >> 1) * 64 + d0;
      p0[u] = *(const f32x4*)pp; p1[u] = *(const f32x4*)(pp + 4);
#pragma unroll
      for (int q = 0; q < 8; ++q) b8[u][q] = *(const s16x8*)(w1t + (size_t)(q * 16 + fr) * 2048 + ks * 32 + fq * 8);
    }
    __builtin_amdgcn_sched_barrier(0);
#pragma unroll
    for (int u = 0; u < 2; ++u) {
      u32x4 au;
      au[0] = pack2(bf2f((unsigned short)a8[u][0]) + p0[u][0], bf2f((unsigned short)a8[u][1]) + p0[u][1]);
      au[1] = pack2(bf2f((unsigned short)a8[u][2]) + p0[u][2], bf2f((unsigned short)a8[u][3]) + p0[u][3]);
      au[2] = pack2(bf2f((unsigned short)a8[u][4]) + p1[u][0], bf2f((unsigned short)a8[u][5]) + p1[u][1]);
      au[3] = pack2(bf2f((unsigned short)a8[u][6]) + p1[u][2], bf2f((unsigned short)a8[u][7]) + p1[u][3]);
      const s16x8 af = __builtin_bit_cast(s16x8, au);
#pragma unroll
      for (int q = 0; q < 8; ++q) acc[q] = MFMA16(af, b8[u][q], acc[q]);
    }
    __builtin_amdgcn_sched_barrier(0);
  }
#pragma unroll
  for (int q = 0; q < 8; ++q)
#pragma unroll
    for (int j = 0; j < 4; ++j) part[(w * 16 + fq * 4 + j) * 132 + q * 16 + fr] = acc[q][j];
  __syncthreads();
  for (int e = tid; e < 16 * 128; e += NTHR) {
    const int row = e >> 7, col = e & 127;
    float s = 0.f;
#pragma unroll
    for (int ww = 0; ww < 8; ++ww) s += part[(ww * 16 + row) * 132 + col];
    hid[row * 136 + col] = f2bf(gelu_tanh(s));
  }
  __syncthreads();
  if (w < 4) {
    f32x4 a2 = f32x4{0.f, 0.f, 0.f, 0.f};
#pragma unroll
    for (int ks = 0; ks < 4; ++ks) {
      s16x8 a8 = *(const s16x8*)(hid + fr * 136 + ks * 32 + fq * 8);
      s16x8 b8 = *(const s16x8*)(w2t + (size_t)(w * 16 + fr) * 128 + ks * 32 + fq * 8);
      a2 = MFMA16(a8, b8, a2);
    }
#pragma unroll
    for (int j = 0; j < 4; ++j) outf[(fq * 4 + j) * 65 + w * 16 + fr] = a2[j];
  }
  __syncthreads();
  if (tid < 256) {
    int row = tid >> 4, c4 = (tid & 15) * 4;
    float v[4]; float ss = 0.f;
#pragma unroll
    for (int j = 0; j < 4; ++j) { v[j] = outf[row * 65 + c4 + j]; ss += v[j] * v[j]; }
    ss += __shfl_xor(ss, 1); ss += __shfl_xor(ss, 2); ss += __shfl_xor(ss, 4); ss += __shfl_xor(ss, 8);
    int nrow = nt * 16 + row;
    if (c == 0) {
      float rr = rsqrtf(ss * (1.f / 64.f) + EPS);
      const float* g = p.g_nsa + (size_t)l * 256 + 64;
#pragma unroll
      for (int j = 0; j < 4; ++j) v[j] = v[j] * rr * g[c4 + j];
    }
    if (nrow >= 511) { v[0] = v[1] = v[2] = v[3] = 0.f; }
    bf16* dst = (bf16*)(p.ws + (c == 0 ? OFF_KC : OFF_VC)) + ((size_t)b * 512 + nrow) * 64 + c4;
    *(uint2*)dst = make_uint2(pack2(v[0], v[1]), pack2(v[2], v[3]));
  }
}

DI float quad_sum(float x) {
  float y = x + __builtin_bit_cast(float, __builtin_amdgcn_update_dpp(0, __builtin_bit_cast(int, x), 0xB1, 0xF, 0xF, true));
  return y + __builtin_bit_cast(float, __builtin_amdgcn_update_dpp(0, __builtin_bit_cast(int, y), 0x4E, 0xF, 0xF, true));
}
DI float fexp2(float x) { return __builtin_amdgcn_exp2f(x); }
DI float flog2(float x) { return __builtin_amdgcn_logf(x); }

DI void kv_load(int tid, const bf16* Kb, const bf16* Vb, size_t stride, int row0, s16x8& kr, s16x8& vr) {
  int row = tid >> 3, ch = (tid & 7) * 8;
  kr = *(const s16x8*)(Kb + (size_t)(row0 + row) * stride + ch);
  if (Vb) vr = *(const s16x8*)(Vb + (size_t)(row0 + row) * stride + ch);
}
DI void kv_store(int tid, char* smem, int buf, bool hasV, const s16x8& kr, const s16x8& vr) {
  int row = tid >> 3, ch = (tid & 7) * 16;
  *(s16x8*)(smem + buf * L_KVB + row * KROW + ch) = kr;
  if (hasV) *(s16x8*)(smem + buf * L_KVB + L_VS + row * KROW + ch) = vr;
}
DI void qk_tile(int tid, const char* kbuf, const s16x8 (&qf)[4], f32x16 (&S)[2]) {
  const int lane = tid & 63, r = lane & 31, half = lane >> 5;
#pragma unroll
  for (int kt = 0; kt < 2; ++kt) {
#pragma unroll
    for (int i = 0; i < 16; ++i) S[kt][i] = 0.f;
#pragma unroll
    for (int ks = 0; ks < 4; ++ks) {
      s16x8 kf = *(const s16x8*)(kbuf + (kt * 32 + r) * KROW + (ks * 16 + half * 8) * 2);
      S[kt] = MFMA32(kf, qf[ks], S[kt]);
    }
  }
}
DI void pv_tile(int tid, const char* vbuf, const f32x16 (&P)[2], f32x16 (&O)[2]) {
  const int lane = tid & 63;
  const int g4 = lane >> 4, q4 = (lane & 15) >> 2, p4 = lane & 3;
#pragma unroll
  for (int kt = 0; kt < 2; ++kt) {
#pragma unroll
    for (int s = 0; s < 2; ++s) {
      u32x4 pk;
      pk[0] = pack2(P[kt][8 * s + 0], P[kt][8 * s + 1]);
      pk[1] = pack2(P[kt][8 * s + 2], P[kt][8 * s + 3]);
      pk[2] = pack2(P[kt][8 * s + 4], P[kt][8 * s + 5]);
      pk[3] = pack2(P[kt][8 * s + 6], P[kt][8 * s + 7]);
      s16x8 pb = __builtin_bit_cast(s16x8, pk);
#pragma unroll
      for (int dt = 0; dt < 2; ++dt) {
        int c0 = dt * 32 + 16 * (g4 & 1);
        int r0 = kt * 32 + 16 * s + 4 * (g4 >> 1);
        const char* a0 = vbuf + (r0 + q4) * KROW + (c0 + 4 * p4) * 2;
        s16x4 lo = __builtin_amdgcn_ds_read_tr16_b64_v4i16((__attribute__((address_space(3))) s16x4*)(a0));
        s16x4 hi = __builtin_amdgcn_ds_read_tr16_b64_v4i16((__attribute__((address_space(3))) s16x4*)(a0 + 8 * KROW));
        s16x8 vf = __builtin_shufflevector(lo, hi, 0, 1, 2, 3, 4, 5, 6, 7);
        O[dt] = MFMA32(vf, pb, O[dt]);
      }
    }
  }
}

template <class K0Fn, class CFn, class StopFn>
DI void kv_pipeline(int tid, const bf16* Kb, const bf16* Vb, size_t stride, int ntiles, K0Fn k0fn, CFn compute, StopFn stop, char* smem) {
  s16x8 k0r, v0r = s16x8{0, 0, 0, 0, 0, 0, 0, 0}, k1r, v1r = s16x8{0, 0, 0, 0, 0, 0, 0, 0};
  const bool hasV = (Vb != nullptr);
  if (ntiles > 0) kv_load(tid, Kb, Vb, stride, k0fn(0), k0r, v0r);
  if (ntiles > 1) kv_load(tid, Kb, Vb, stride, k0fn(1), k1r, v1r);
  __syncthreads();
  if (ntiles > 0) kv_store(tid, smem, 0, hasV, k0r, v0r);
  if (ntiles > 2) kv_load(tid, Kb, Vb, stride, k0fn(2), k0r, v0r);
  for (int idx = 0; idx < ntiles; idx += 2) {
    __syncthreads();
    if (stop()) break;
    if (idx + 1 < ntiles) kv_store(tid, smem, 1, hasV, k1r, v1r);
    if (idx + 3 < ntiles) kv_load(tid, Kb, Vb, stride, k0fn(idx + 3), k1r, v1r);
    compute(idx, k0fn(idx), 0);
    if (idx + 1 >= ntiles) break;
    __syncthreads();
    if (stop()) break;
    if (idx + 2 < ntiles) kv_store(tid, smem, 0, hasV, k0r, v0r);
    if (idx + 4 < ntiles) kv_load(tid, Kb, Vb, stride, k0fn(idx + 4), k0r, v0r);
    compute(idx + 1, k0fn(idx + 1), 1);
  }
}

DI void softmax_step(int tid, int cls, f32x16 (&S)[2], f32x16 (&O)[2], float& m, float& l, int k0, int qpos, float slope2,
                     int kmul, int kadd, int W, bool extra) {
  const int half = (tid & 63) >> 5;
  const int dbase = qpos - (k0 + 4 * half) * kmul - kadd;
  float mx = NEGB;
  float c;
  if (cls != 4) {
    const float sk = slope2 * (float)kmul, b0 = -slope2 * (float)dbase;
    if (cls == 1) {
#pragma unroll
      for (int kt = 0; kt < 2; ++kt)
#pragma unroll
        for (int i = 0; i < 16; ++i) {
          float t = fmaf(sk, (float)(kt * 32 + (i & 3) + 8 * (i >> 2)), S[kt][i]);
          S[kt][i] = t;
          mx = fmaxf(mx, t);
        }
    } else if (cls == 2) {
      const int hi = extra ? dbase : -1;
#pragma unroll
      for (int kt = 0; kt < 2; ++kt)
#pragma unroll
        for (int i = 0; i < 16; ++i) {
          const int off = kt * 32 + (i & 3) + 8 * (i >> 2);
          float t = fmaf(sk, (float)off, S[kt][i]);
          t = (off * kmul <= hi) ? t : NEGB;
          S[kt][i] = t;
          mx = fmaxf(mx, t);
        }
    } else {
      const int lo = extra ? dbase - W : 0x7fffffff;
#pragma unroll
      for (int kt = 0; kt < 2; ++kt)
#pragma unroll
        for (int i = 0; i < 16; ++i) {
          const int off = kt * 32 + (i & 3) + 8 * (i >> 2);
          float t = fmaf(sk, (float)off, S[kt][i]);
          t = (off * kmul >= lo) ? t : NEGB;
          S[kt][i] = t;
          mx = fmaxf(mx, t);
        }
    }
    mx += b0;
    mx = fmaxf(mx, __shfl_xor(mx, 32));
    if (__any(mx > m + 8.f)) {
      float mn = fmaxf(m, mx), alpha = fexp2(m - mn);
      m = mn; l *= alpha;
#pragma unroll
      for (int dt = 0; dt < 2; ++dt)
#pragma unroll
        for (int i = 0; i < 16; ++i) O[dt][i] *= alpha;
    }
    c = fmaxf(m, -1e20f) - b0;
  } else {
#pragma unroll
    for (int kt = 0; kt < 2; ++kt)
#pragma unroll
      for (int i = 0; i < 16; ++i) {
        int d = dbase - (kt * 32 + (i & 3) + 8 * (i >> 2)) * kmul;
        bool valid = extra && ((unsigned)d <= (unsigned)W);
        float s2 = valid ? fmaf(-slope2, (float)d, S[kt][i]) : NEGB;
        S[kt][i] = s2;
        mx = fmaxf(mx, s2);
      }
    mx = fmaxf(mx, __shfl_xor(mx, 32));
    if (__any(mx > m + 8.f)) {
      float mn = fmaxf(m, mx), alpha = fexp2(m - mn);
      m = mn; l *= alpha;
#pragma unroll
      for (int dt = 0; dt < 2; ++dt)
#pragma unroll
        for (int i = 0; i < 16; ++i) O[dt][i] *= alpha;
    }
    c = fmaxf(m, -1e20f);
  }
  float ps = 0.f;
#pragma unroll
  for (int kt = 0; kt < 2; ++kt)
#pragma unroll
    for (int i = 0; i < 16; ++i) {
      float pv = fexp2(S[kt][i] - c);
      S[kt][i] = pv;
      ps += pv;
    }
  l += ps;
}

DI int tile_class(int qmin, int qmax, int k0, int kmul, int kadd, int W) {
  const int kpmin = k0 * kmul + kadd, kpmax = (k0 + 63) * kmul + kadd;
  const int dmin = qmin - kpmax, dmax = qmax - kpmin;
  if (dmax < 0 || dmin > W) return 0;
  if (dmin >= 0) return (dmax <= W) ? 1 : 3;
  return (dmax <= W) ? 2 : 4;
}

template <class K0Fn, class ExFn>
DI void flash_softmax(int tid, const bf16* Kb, const bf16* Vb, size_t kvstride, int ntiles, K0Fn k0fn, ExFn exfn,
                      const s16x8 (&qf)[4], int qpos, int qmin, int qmax, float slope2, int kmul, int kadd, int W,
                      f32x16 (&O)[2], float& m, float& l, char* smem) {
  kv_pipeline(tid, Kb, Vb, kvstride, ntiles, k0fn,
              [&](int idx, int k0, int buf) {
                int cls = tile_class(qmin, qmax, k0, kmul, kadd, W);
                const bool ex = exfn(k0);
                if (!__any(ex)) cls = 0;
                else if (cls == 1 && !__all(ex)) cls = 2;
                if (cls != 0) {
                  f32x16 S[2];
                  qk_tile(tid, smem + buf * L_KVB, qf, S);
                  softmax_step(tid, cls, S, O, m, l, k0, qpos, slope2, kmul, kadd, W, ex);
                  pv_tile(tid, smem + buf * L_KVB + L_VS, S, O);
                }
              },
              []() { return false; }, smem);
}

DI void load_q(int tid, const bf16* qrow, s16x8 (&qf)[4]) {
  const int half = (tid & 63) >> 5;
#pragma unroll
  for (int ks = 0; ks < 4; ++ks) qf[ks] = *(const s16x8*)(qrow + ks * 16 + half * 8);
}
DI void zero_state(f32x16 (&O)[2], float& m, float& l) {
#pragma unroll
  for (int dt = 0; dt < 2; ++dt)
#pragma unroll
    for (int i = 0; i < 16; ++i) O[dt][i] = 0.f;
  m = NEGB; l = 0.f;
}
DI float sigmoidf_(float x) { return 1.f / (1.f + __expf(-x)); }

__device__ void nsa_item(const Params& p, int item, char* smem) {
  const int tid = tid_opaque(), w = tid >> 6, lane = tid & 63, r = lane & 31, half = lane >> 5;
  const int b = item >> 7, t0 = (item & 127) * 64;
  const int tq = w * 8 + (r >> 2), h = r & 3, t = t0 + tq;
  const int qmin = t0 + w * 8, qmax = qmin + 7;
  const bf16* proj = (const bf16*)(p.ws + OFF_PROJ);
  const bf16* pb = proj + (size_t)b * SEQ * 64;
  const size_t CH = (size_t)NT * 64;
  const bf16* qrow = pb + h * CH + (size_t)t * 64;
  float* imp = (float*)(smem + L_IMP);
  float* impe = (float*)(smem + L_IMPE);
  unsigned* selm = (unsigned*)(smem + L_SELM);
  int* tlist = (int*)(smem + L_LIST);
  const float slope2 = fexp2(-0.8f * (float)(h + 7)) * LOG2E;
  float gate[3];
#pragma unroll
  for (int br = 0; br < 3; ++br) gate[br] = sigmoidf_(bf2f(pb[46 * CH + (size_t)t * 64 + h * 3 + br]));
  s16x8 qf[4];
  load_q(tid, qrow, qf);
  f32x16 Of[2];
#pragma unroll
  for (int dt = 0; dt < 2; ++dt)
#pragma unroll
    for (int i = 0; i < 16; ++i) Of[dt][i] = 0.f;

  __syncthreads();
  for (int i = tid; i < 64 * IMPW / 4; i += NTHR) { ((f32x4*)imp)[i] = f32x4{0.f, 0.f, 0.f, 0.f}; ((f32x4*)impe)[i] = f32x4{0.f, 0.f, 0.f, 0.f}; }

  const bf16* kc = (const bf16*)(p.ws + OFF_KC) + (size_t)b * 512 * 64;
  const bf16* vc = (const bf16*)(p.ws + OFF_VC) + (size_t)b * 512 * 64;
  const int ntc = ((t0 >> 4) + 2) / 64 + 1;
  f32x16 O[2]; float m, l;
  for (int q_ = 0; q_ < REP_CMPA; ++q_) {
  zero_state(O, m, l);
  flash_softmax(tid, kc, vc, 64, ntc, [](int i) { return i * 64; }, [](int) { return true; }, qf, t, qmin, qmax, slope2, 16, 31, 1 << 30, O, m, l, smem);
  }
  float lt = l + __shfl_xor(l, 32);
  {
    float sc = gate[0] / fmaxf(lt, 1e-30f);
#pragma unroll
    for (int dt = 0; dt < 2; ++dt)
#pragma unroll
      for (int i = 0; i < 16; ++i) Of[dt][i] += sc * O[dt][i];
  }
  {
    const float linv = 1.f / fmaxf(lt, 1e-30f);
    const float mc = fmaxf(m, -1e20f);
    kv_pipeline(tid, kc, nullptr, 64, ntc, [](int i) { return i * 64; },
                [&](int idx, int k0, int buf) {
                  const int cls = tile_class(qmin, qmax, k0, 16, 31, 1 << 30);
                  float Gq[2][4], El[2][4];
                  if (cls != 0) {
                    f32x16 S[2];
                    qk_tile(tid, smem + buf * L_KVB, qf, S);
                    const int dbase = t - (k0 + 4 * half) * 16 - 31;
#pragma unroll
                    for (int kt = 0; kt < 2; ++kt)
#pragma unroll
                      for (int g = 0; g < 4; ++g) {
                        float qs = 0.f, last = 0.f;
#pragma unroll
                        for (int e = 0; e < 4; ++e) {
                          int i = 4 * g + e;
                          int d = dbase - (kt * 32 + e + 8 * g) * 16;
                          float s2 = (d >= 0) ? fmaf(-slope2, (float)d, S[kt][i]) : NEGB;
                          float pv = fexp2(s2 - mc) * linv;
                          qs += pv; last = pv;
                        }
                        Gq[kt][g] = quad_sum(qs); El[kt][g] = quad_sum(last);
                      }
                    if (h == 0) {
#pragma unroll
                      for (int kt = 0; kt < 2; ++kt)
#pragma unroll
                        for (int g = 0; g < 4; ++g) { int j = 16 * idx + kt * 8 + 2 * g + half; imp[tq * IMPW + j] = Gq[kt][g]; impe[tq * IMPW + j + 1] = El[kt][g]; }
                    }
                  }
                },
                []() { return false; }, smem);
  }
  __syncthreads();
  {
    const int tk = lane >> 3, sub = lane & 7;
    const int tq2 = w * 8 + tk, t2 = t0 + tq2, cur = t2 >> 6;
    unsigned long long key[16];
#pragma unroll
    for (int e = 0; e < 16; ++e) {
      int j = sub * 16 + e;
      float v = imp[tq2 * IMPW + j] + impe[tq2 * IMPW + j];
      bool forced = (j == 0) || (j == cur) || (j == cur - 1);
      if (forced) v += 1e4f;
      bool vis = (64 * j <= t2);
      unsigned hi = vis ? (__float_as_uint(v) + 1u) : 0u;
      key[e] = ((unsigned long long)hi << 32) | (unsigned)(128 - j);
    }
    unsigned mk[4] = {0u, 0u, 0u, 0u};
    for (int it = 0; it < 16; ++it) {
      unsigned long long best = key[0];
#pragma unroll
      for (int e = 1; e < 16; ++e) best = (key[e] > best) ? key[e] : best;
#define TOPK_DPP_STEP(CTRL) { \
        const unsigned lo_ = (unsigned)__builtin_amdgcn_update_dpp(0, (int)(unsigned)best, CTRL, 0xF, 0xF, true); \
        const unsigned hi_ = (unsigned)__builtin_amdgcn_update_dpp(0, (int)(unsigned)(best >> 32), CTRL, 0xF, 0xF, true); \
        const unsigned long long ob_ = ((unsigned long long)hi_ << 32) | lo_; \
        best = (ob_ > best) ? ob_ : best; }
      TOPK_DPP_STEP(0xB1) TOPK_DPP_STEP(0x4E) TOPK_DPP_STEP(0x141)
#undef TOPK_DPP_STEP
      int js = 128 - (int)(best & 255ull);
      if ((best >> 32) != 0ull) {
#pragma unroll
        for (int q = 0; q < 4; ++q) if ((js >> 5) == q) mk[q] |= 1u << (js & 31);
      }
#pragma unroll
      for (int e = 0; e < 16; ++e) if ((unsigned)key[e] == (unsigned)best) key[e] = 0ull;
    }
    if (sub == 0) {
#pragma unroll
      for (int q = 0; q < 4; ++q) selm[tq2 * 4 + q] = mk[q];
    }
  }
  __syncthreads();
  if (w == 0) {
    unsigned um[4];
#pragma unroll
    for (int q = 0; q < 4; ++q) {
      unsigned v = selm[lane * 4 + q];
#pragma unroll
      for (int o = 1; o < 64; o <<= 1) v |= __shfl_xor(v, o);
      um[q] = v;
    }
    const bool b0 = ((lane < 32 ? um[0] : um[1]) >> (lane & 31)) & 1u;
    const bool b1 = ((lane < 32 ? um[2] : um[3]) >> (lane & 31)) & 1u;
    const unsigned long long m0 = __ballot(b0), m1 = __ballot(b1);
    const unsigned long long below = (lane == 0) ? 0ull : (~0ull >> (64 - lane));
    const int c0 = __popcll(m0);
    if (b0) tlist[1 + __popcll(m0 & below)] = lane * 64;
    if (b1) tlist[1 + c0 + __popcll(m1 & below)] = (lane + 64) * 64;
    if (lane == 0) tlist[0] = c0 + __popcll(m1);
  }
  __syncthreads();
  {
    const int nsel = tlist[0];
    const unsigned* myselm = selm + tq * 4;
    for (int q_ = 0; q_ < REP_SEL; ++q_) {
    zero_state(O, m, l);
    flash_softmax(tid, pb + 6 * CH, pb + 7 * CH, 64, nsel, [&](int i) { return tlist[1 + i]; },
                  [&](int k0) { int j = k0 >> 6; return ((myselm[j >> 5] >> (j & 31)) & 1u) != 0u; },
                  qf, t, qmin, qmax, slope2, 1, 0, 1 << 30, O, m, l, smem);
    }
    float lt2 = l + __shfl_xor(l, 32);
    float sc = gate[1] / fmaxf(lt2, 1e-30f);
#pragma unroll
    for (int dt = 0; dt < 2; ++dt)
#pragma unroll
      for (int i = 0; i < 16; ++i) Of[dt][i] += sc * O[dt][i];
  }
  {
    int kfirst = t0 - 511; if (kfirst < 0) kfirst = 0;
    const int tfirst = kfirst >> 6, tlast = (t0 + 63) >> 6;
    for (int q_ = 0; q_ < REP_WIN; ++q_) {
    zero_state(O, m, l);
    flash_softmax(tid, pb + 8 * CH, pb + 9 * CH, 64, tlast - tfirst + 1, [&](int i) { return (tfirst + i) * 64; }, [](int) { return true; },
                  qf, t, qmin, qmax, slope2, 1, 0, 511, O, m, l, smem);
    }
    float lt3 = l + __shfl_xor(l, 32);
    float sc = gate[2] / fmaxf(lt3, 1e-30f);
#pragma unroll
    for (int dt = 0; dt < 2; ++dt)
#pragma unroll
      for (int i = 0; i < 16; ++i) Of[dt][i] += sc * O[dt][i];
  }
  bf16* cat = (bf16*)(p.ws + OFF_CAT) + ((size_t)h * NT + (size_t)b * SEQ + t) * 64;
#pragma unroll
  for (int dt = 0; dt < 2; ++dt)
#pragma unroll
    for (int g = 0; g < 4; ++g) {
      int d = dt * 32 + 8 * g + 4 * half;
      *(uint2*)(cat + d) = make_uint2(pack2(Of[dt][4 * g], Of[dt][4 * g + 1]), pack2(Of[dt][4 * g + 2], Of[dt][4 * g + 3]));
    }
}

__device__ void dil_item(const Params& p, int item, char* smem) {
  const int tid = tid_opaque(), w = tid >> 6, lane = tid & 63, r = lane & 31, half = lane >> 5;
  const int ti = item & 31, hh = (item >> 5) & 1, g = (item >> 6) % 3, b = item / 192;
  const int sh = 2 * g, rr = 1 << sh, nper = SEQ >> sh, tpc = nper >> 8;
  const int c = ti / tpc, i0 = (ti % tpc) * 256;
  const bf16* pb = (const bf16*)(p.ws + OFF_PROJ) + ((size_t)b * SEQ + (size_t)c * nper) * 64;
  const size_t CH = (size_t)NT * 64;
  const int head = g * 2 + hh;
  const int qi = i0 + w * 32 + r;
  const int qmin = i0 + w * 32, qmax = qmin + 31;
  s16x8 qf[4];
  load_q(tid, pb + (10 + head) * CH + (size_t)qi * 64, qf);
  const float slope2 = fexp2(-0.8f * (float)(head + 1)) * (float)rr * LOG2E;
  f32x16 O[2]; float m, l;
  zero_state(O, m, l);
  const int kfirst = (i0 >= 128) ? i0 - 128 : 0;
  const int nt = (i0 + 256 - kfirst) >> 6;
  {
    const bf16* Kb = pb + (16 + head) * CH;
    const bf16* Vb = pb + (22 + head) * CH;
    s16x8 kr[6], vr[6];
#pragma unroll
    for (int j = 0; j < 6; ++j)
      if (j < nt) kv_load(tid, Kb, Vb, 64, kfirst + j * 64, kr[j], vr[j]);
    __syncthreads();
#pragma unroll
    for (int j = 0; j < 6; ++j)
      if (j < nt) kv_store(tid, smem, j, true, kr[j], vr[j]);
    __syncthreads();
#pragma unroll 1
    for (int j = 0; j < nt; ++j) {
      const int k0 = kfirst + j * 64;
      const int cls = tile_class(qmin, qmax, k0, 1, 0, 128);
      if (cls != 0) {
        f32x16 S[2];
        qk_tile(tid, smem + j * L_KVB, qf, S);
        softmax_step(tid, cls, S, O, m, l, k0, qi, slope2, 1, 0, 128, true);
        pv_tile(tid, smem + j * L_KVB + L_VS, S, O);
      }
    }
  }
  float lt = l + __shfl_xor(l, 32);
  float linv = 1.f / fmaxf(lt, 1e-30f);
  const size_t prow = ((size_t)(b * 3 + g) * SEQ + (size_t)c * nper + qi);
  float* od = (float*)(p.ws + OFF_DILO) + (prow * 2 + hh) * 64;
#pragma unroll
  for (int dt = 0; dt < 2; ++dt)
#pragma unroll
    for (int q = 0; q < 4; ++q) {
      int d = dt * 32 + 8 * q + 4 * half;
      *(f32x4*)(od + d) = f32x4{O[dt][4 * q] * linv, O[dt][4 * q + 1] * linv, O[dt][4 * q + 2] * linv, O[dt][4 * q + 3] * linv};
    }
  if (half == 0) ((float*)(p.ws + OFF_DILL))[prow * 2 + hh] = m + flog2(fmaxf(lt, 1e-30f));
}

__device__ void dilc_item(const Params& p, int item) {
  const int tid = tid_opaque();
  const int tokg = item * 64 + (tid >> 3), hh = (tid >> 2) & 1, d0 = (tid & 3) * 16;
  const int b = tokg >> 13, t = tokg & (SEQ - 1);
  const float* dilo = (const float*)(p.ws + OFF_DILO);
  const float* dill = (const float*)(p.ws + OFF_DILL);
  float ls[3]; const float* op[3];
#pragma unroll
  for (int g = 0; g < 3; ++g) {
    int sh = 2 * g;
    size_t prow = (size_t)(b * 3 + g) * SEQ + (size_t)(t & ((1 << sh) - 1)) * (SEQ >> sh) + (t >> sh);
    ls[g] = dill[prow * 2 + hh];
    op[g] = dilo + (prow * 2 + hh) * 64 + d0;
  }
  float mx = fmaxf(ls[0], fmaxf(ls[1], ls[2]));
  float e0 = fexp2(ls[0] - mx), e1 = fexp2(ls[1] - mx), e2 = fexp2(ls[2] - mx);
  float inv = 1.f / (e0 + e1 + e2);
  e0 *= inv; e1 *= inv; e2 *= inv;
  bf16* cat = (bf16*)(p.ws + OFF_CAT) + ((size_t)(4 + hh) * NT + tokg) * 64 + d0;
  f32x4 va[3][4];
#pragma unroll
  for (int g = 0; g < 3; ++g)
#pragma unroll
    for (int q = 0; q < 4; ++q) va[g][q] = *(const f32x4*)(op[g] + 4 * q);
  __builtin_amdgcn_sched_barrier(0);
  u32x4 o0, o1;
#pragma unroll
  for (int q = 0; q < 4; ++q) {
    const f32x4 a = va[0][q], bb = va[1][q], cc = va[2][q];
    float v0 = e0 * a[0] + e1 * bb[0] + e2 * cc[0], v1 = e0 * a[1] + e1 * bb[1] + e2 * cc[1];
    float v2 = e0 * a[2] + e1 * bb[2] + e2 * cc[2], v3 = e0 * a[3] + e1 * bb[3] + e2 * cc[3];
    if (q < 2) { o0[2 * q] = pack2(v0, v1); o0[2 * q + 1] = pack2(v2, v3); }
    else { o1[2 * (q - 2)] = pack2(v0, v1); o1[2 * (q - 2) + 1] = pack2(v2, v3); }
  }
  *(u32x4*)cat = o0; *(u32x4*)(cat + 8) = o1;
}

__device__ void sb_item(const Params& p, int item, char* smem) {
  const int tid = tid_opaque(), w = tid >> 6, lane = tid & 63, r = lane & 31, half = lane >> 5;
  const int ti = item & 31, h = (item >> 5) % 6, b = item / 192;
  const int t0 = ti * 256, tw = t0 + w * 32, t = tw + r;
  const size_t CH = (size_t)NT * 64;
  const bf16* pb = (const bf16*)(p.ws + OFF_PROJ) + (size_t)b * SEQ * 64;
  const bf16* Kb = pb + (34 + h) * CH;
  const bf16* Vb = pb + (40 + h) * CH;
  int* flags = (int*)(smem + L_SSL);
  s16x8 qf[4];
  load_q(tid, pb + (28 + h) * CH + (size_t)t * 64, qf);
  f32x16 O[2];
#pragma unroll
  for (int dt = 0; dt < 2; ++dt)
#pragma unroll
    for (int i = 0; i < 16; ++i) O[dt][i] = 0.f;
  float Tc = 1.f;
  const int ntiles = (t0 >> 6) + 4;
  int hi = ntiles - 1;
  bool wdone = false;
  for (;;) {
    const int nst = (hi + 1 < 7) ? hi + 1 : 7;
    {
      s16x8 kr[7], vr[7];
#pragma unroll
      for (int j = 0; j < 7; ++j)
        if (j < nst) kv_load(tid, Kb, Vb, 64, (hi - j) * 64, kr[j], vr[j]);
      __syncthreads();
#pragma unroll
      for (int j = 0; j < 7; ++j)
        if (j < nst) kv_store(tid, smem, j, true, kr[j], vr[j]);
    }
    __syncthreads();
#pragma unroll 1
    for (int j = 0; j < nst; ++j) {
      const int k0 = (hi - j) * 64;
      if (!wdone && k0 < tw + 31) {
        const char* kb = smem + j * L_KVB;
        const bool allc = (k0 + 63 < tw);
        f32x16 S[2];
        qk_tile(tid, kb, qf, S);
        float ff[2][16];
#pragma unroll
        for (int kt = 0; kt < 2; ++kt)
#pragma unroll
          for (int i = 0; i < 16; ++i) {
            const float z2 = fmaxf(S[kt][i], -60.f);
            const float e = fexp2(-z2);
            float be = __builtin_amdgcn_rcpf(1.f + e);
            float fv = e * be;
            if (!allc) {
              const int kj = k0 + kt * 32 + (i & 3) + 8 * (i >> 2) + 4 * half;
              const bool causal = kj < t;
              be = causal ? be : 0.f;
              fv = causal ? fv : 1.f;
            }
            ff[kt][i] = fv;
            S[kt][i] = be;
          }
        float Gq[2][4], Go[2][4], P[2][4];
#pragma unroll
        for (int kt = 0; kt < 2; ++kt)
#pragma unroll
          for (int g = 0; g < 4; ++g) {
            Gq[kt][g] = (ff[kt][4 * g] * ff[kt][4 * g + 1]) * (ff[kt][4 * g + 2] * ff[kt][4 * g + 3]);
            Go[kt][g] = __shfl_xor(Gq[kt][g], 32);
            P[kt][g] = Gq[kt][g] * Go[kt][g];
          }
        const float tot1 = (P[1][0] * P[1][1]) * (P[1][2] * P[1][3]);
        const float tot0 = (P[0][0] * P[0][1]) * (P[0][2] * P[0][3]);
        float Sfx[2][4];
        Sfx[1][3] = 1.f; Sfx[1][2] = P[1][3]; Sfx[1][1] = Sfx[1][2] * P[1][2]; Sfx[1][0] = Sfx[1][1] * P[1][1];
        Sfx[0][3] = tot1; Sfx[0][2] = Sfx[0][3] * P[0][3]; Sfx[0][1] = Sfx[0][2] * P[0][2]; Sfx[0][0] = Sfx[0][1] * P[0][1];
#pragma unroll
        for (int kt = 0; kt < 2; ++kt)
#pragma unroll
          for (int g = 0; g < 4; ++g) {
            const float T = Tc * Sfx[kt][g] * (half == 0 ? Go[kt][g] : 1.f);
            const float a3 = T, a2 = a3 * ff[kt][4 * g + 3], a1 = a2 * ff[kt][4 * g + 2], a0 = a1 * ff[kt][4 * g + 1];
            S[kt][4 * g] *= a0;
            S[kt][4 * g + 1] *= a1;
            S[kt][4 * g + 2] *= a2;
            S[kt][4 * g + 3] *= a3;
          }
        Tc *= tot0 * tot1;
        pv_tile(tid, kb + L_VS, S, O);
        wdone = __all(Tc < 1e-36f) != 0;
      }
    }
    hi -= nst;
    if (lane == 0) flags[w] = wdone ? 1 : 0;
    __syncthreads();
    const bool alld = (flags[0] & flags[1] & flags[2] & flags[3] & flags[4] & flags[5] & flags[6] & flags[7]) != 0;
    if (hi < 0 || alld) break;
  }
  bf16* cat = (bf16*)(p.ws + OFF_CAT) + ((size_t)(6 + h) * NT + (size_t)b * SEQ + t) * 64;
#pragma unroll
  for (int dt = 0; dt < 2; ++dt)
#pragma unroll
    for (int g = 0; g < 4; ++g) {
      int d = dt * 32 + 8 * g + 4 * half;
      *(uint2*)(cat + d) = make_uint2(pack2(O[dt][4 * g], O[dt][4 * g + 1]), pack2(O[dt][4 * g + 2], O[dt][4 * g + 3]));
    }
}

#define XB_TMO      128
#define XB_XCNT(j)  (256  + 64 * (j))
#define XB_XSUB(j)  (1280 + 64 * (j))
#define XB_XGEN(j)  (2304 + 64 * (j))
#define XB_TOP      3328
#define XB_TOPGEN   3392
#define XCD_BAR_WORDS 3456
#define XB_SPIN_CAP (1u << 22)
DI unsigned xb_ld(unsigned* p) { return __hip_atomic_load(p, __ATOMIC_RELAXED, __HIP_MEMORY_SCOPE_AGENT); }
DI unsigned xb_add(unsigned* p, unsigned v) { return __hip_atomic_fetch_add(p, v, __ATOMIC_RELAXED, __HIP_MEMORY_SCOPE_AGENT); }
DI unsigned xb_xcc_id() { return (unsigned)__builtin_amdgcn_s_getreg((3 << 11) | 20) & 0xFu; }
#define XB_SPIN(cond, bar) do { unsigned _sp = 0; while (cond) { __builtin_amdgcn_s_sleep(1); \
    if ((++_sp & 255u) == 0u) { if (xb_ld(&(bar)[XB_TMO])) break; if (_sp > XB_SPIN_CAP) { atomicAdd(&(bar)[XB_TMO], 1u); break; } } } } while (0)
struct XcdBarrier { unsigned* bar; unsigned x; volatile LAS unsigned* st; };
DI XcdBarrier xcd_barrier_post(unsigned* bar, volatile LAS unsigned* st) {
  XcdBarrier b; b.bar = bar; b.x = xb_xcc_id(); b.st = st;
  if (threadIdx.x == 0) (void)xb_add(&bar[XB_XCNT(b.x)], 1u);
  return b;
}
DI void xcd_barrier_complete(unsigned* bar, unsigned x, unsigned& nloc, unsigned& nx) {
  const unsigned G = gridDim.x;
  unsigned sum, cnt, mine, sp = 0u;
  for (;;) {
    sum = 0u; cnt = 0u; mine = 0u;
#pragma unroll
    for (unsigned j = 0; j < 16; ++j) { const unsigned c = xb_ld(&bar[XB_XCNT(j)]); sum += c; cnt += (c > 0u) ? 1u : 0u; mine = (j == x) ? c : mine; }
    if (sum == G) break;
    __builtin_amdgcn_s_sleep(1);
    if ((++sp & 255u) == 0u) { if (xb_ld(&bar[XB_TMO])) break; if (sp > XB_SPIN_CAP) { atomicAdd(&bar[XB_TMO], 1u); break; } }
  }
  nloc = mine > 0u ? mine : 1u; nx = cnt > 0u ? cnt : 1u;
}
DI void xcd_barrier(const XcdBarrier& b) {
  asm volatile("s_waitcnt vmcnt(0)" ::: "memory");
  __syncthreads();
  if (threadIdx.x == 0) {
    unsigned* bar = b.bar;
    __builtin_amdgcn_s_waitcnt(0);
    unsigned nloc = b.st[0], nx = b.st[1];
    if (nloc == 0u) { xcd_barrier_complete(bar, b.x, nloc, nx); b.st[0] = nloc; b.st[1] = nx; }
    const unsigned old = xb_add(&bar[XB_XSUB(b.x)], 1u);
    const unsigned gen = old / nloc;
    if (old + 1u == (gen + 1u) * nloc) {
      __builtin_amdgcn_fence(__ATOMIC_RELEASE, "agent");
      asm volatile("s_waitcnt vmcnt(0)" ::: "memory");
      const unsigned og = xb_add(&bar[XB_TOP], 1u);
      const unsigned tg = og / nx;
      if (og + 1u == (tg + 1u) * nx) xb_add(&bar[XB_TOPGEN], 1u);
      else XB_SPIN(xb_ld(&bar[XB_TOPGEN]) == tg, bar);
      __builtin_amdgcn_fence(__ATOMIC_ACQUIRE, "agent");
      xb_add(&bar[XB_XGEN(b.x)], 1u);
      asm volatile("s_waitcnt vmcnt(0)" ::: "memory");
    } else {
      XB_SPIN(xb_ld(&bar[XB_XGEN(b.x)]) == gen, bar);
      __builtin_amdgcn_fence(__ATOMIC_ACQUIRE, "agent");
      asm volatile("s_waitcnt vmcnt(0)" ::: "memory");
    }
  }
  __syncthreads();
}

#define GSYNC() do { for (int rs_ = 0; rs_ < REP_SYNC; ++rs_) xcd_barrier(xb); } while (0)
__global__ void __launch_bounds__(512, 2) fwd_megakernel(Params p) {
  extern __shared__ __attribute__((aligned(16))) char smem[];
  cg::grid_group grid = cg::this_grid();
  const int G = gridDim.x, bid = blockIdx.x;
  if (p.ws == nullptr) grid.sync();
  volatile LAS unsigned* xst = (volatile LAS unsigned*)(smem + L_XB);
  if (threadIdx.x < 4) xst[threadIdx.x] = 0u;
  __syncthreads();
  XcdBarrier xb = xcd_barrier_post((unsigned*)(p.ws + OFF_BAR), xst);

  for (int rep = 0; rep < REP_P0; ++rep) { if (rep) xcd_barrier(xb); phase0(p, smem); }
  GSYNC();

  for (int l = 0; l < 2; ++l) {
    EpiArgs ea;
    ea.layer = l;
    ea.g_nsa = p.g_nsa + l * 256;
    ea.g_dil = p.g_dil + l * 128;
    ea.ssq = (const float*)(p.ws + OFF_SSQ);
    ea.ssq_out = (float*)(p.ws + OFF_SSQ);
    ea.resid = nullptr; ea.outf = nullptr;
    ea.outb = (bf16*)(p.ws + OFF_PROJ);
    for (int rep = 0; rep < REP_P1; ++rep) {
    if (rep) xcd_barrier(xb);
    gemm8<EPI_PROJ>((const bf16*)(p.ws + OFF_XB), (const bf16*)(p.ws + OFF_WIN) + (size_t)l * NP * DM, DM, NP / 256, (NT / 256) * (NP / 256), ea, smem);
    }
    GSYNC();
    for (int rep = 0; rep < REP_P2A; ++rep) {
    if (rep) xcd_barrier(xb);
    for (int it = bid; it < 128 + 384; it += G) {
      if (it < 128) { for (int q = 0; q < REP_CMP; ++q) compress_item(p, l, it, smem); }
      else { for (int q = 0; q < REP_DIL; ++q) dil_item(p, it - 128, smem); }
    }
    }
    GSYNC();
    for (int it = bid; it < 256; it += G) { for (int q = 0; q < REP_NSA; ++q) nsa_item(p, it, smem); }
    {
      unsigned* qcnt = (unsigned*)(p.ws + OFF_QCNT) + l * 64;
      volatile int* qslot = (volatile int*)(smem + L_QS);
      const int nconv = (l == 0) ? WCONV_NCHUNK : 0;
      const int qtotal = 384 + nconv + 256;
      for (;;) {
        __syncthreads();
        if (threadIdx.x == 0) *qslot = (int)atomicAdd(qcnt, 1u);
        __syncthreads();
        const int q = *qslot;
        if (q >= qtotal) break;
        if (q < 384) { for (int q2 = 0; q2 < REP_SB; ++q2) sb_item(p, q, smem); }
        else if (q < 384 + nconv) {
          const int c0 = (q - 384) * WCONV_CHUNK;
          const int c1 = (c0 + WCONV_CHUNK < WCONV_QTILES) ? c0 + WCONV_CHUNK : WCONV_QTILES;
          const int tidq = tid_opaque();
          for (int i = c0 + (tidq >> 7); i < c1; i += 4) {
            int iv = i; asm volatile("" : "+v"(iv));
            const int li = (iv < WCONV_L0Q) ? 0 : 1;
            const TrDesc d = wconv_desc(p, li, li ? iv - WCONV_L0Q : iv + 768);
            tr_direct(d, tidq & 127);
          }
        } else dilc_item(p, q - 384 - nconv);
      }
    }
    GSYNC();
    ea.outb = (bf16*)(p.ws + OFF_XB);
    ea.resid = nullptr;
    ea.outf = nullptr;
    gemm8<EPI_RES>((const bf16*)(p.ws + OFF_CAT), (const bf16*)(p.ws + OFF_WOUT) + (size_t)l * DM * DCAT, DCAT, DM / 256, (NT / 256) * (DM / 256), ea, smem);
    GSYNC();
    ea.outb = (bf16*)(p.ws + OFF_U);
    for (int rep = 0; rep < REP_P3B; ++rep) {
    if (rep) xcd_barrier(xb);
    gemm8<EPI_UP>((const bf16*)(p.ws + OFF_XB), (const bf16*)(p.ws + OFF_WUP) + (size_t)l * DFF * DM, DM, DFF / 256, (NT / 256) * (DFF / 256), ea, smem);
    }
    GSYNC();
    ea.outb = (bf16*)(p.ws + OFF_XB);
    ea.resid = nullptr;
    ea.outf = (l == 1) ? p.out : nullptr;
    gemm8<EPI_RES>((const bf16*)(p.ws + OFF_U), (const bf16*)(p.ws + OFF_WDN) + (size_t)l * DM * DFF, DFF, DM / 256, (NT / 256) * (DM / 256), ea, smem);
    if (l == 0) GSYNC();
  }
}

extern "C" void kernel_launch(void* const* d_in, const int* in_sizes, int n_in, void* d_out, int out_size, void* d_ws, size_t ws_size,
                              hipStream_t stream) {
  static int grid_blocks = 0;
  if (!grid_blocks) {
    int dev = 0, cus = 0, per_cu = 0;
    hipGetDevice(&dev);
    hipDeviceGetAttribute(&cus, hipDeviceAttributeMultiprocessorCount, dev);
    hipFuncSetAttribute((const void*)fwd_megakernel, hipFuncAttributeMaxDynamicSharedMemorySize, LDS_BYTES);
    hipOccupancyMaxActiveBlocksPerMultiprocessor(&per_cu, (const void*)fwd_megakernel, NTHR, LDS_BYTES);
    per_cu = 1;
    grid_blocks = cus * per_cu;
    if (ws_size < WS_NEED) fprintf(stderr, "workspace too small: %zu < %zu\n", ws_size, (size_t)WS_NEED);
  }
  Params p{};
  p.x = (const float*)d_in[0]; p.norm_mix = (const float*)d_in[1]; p.norm_mlp = (const float*)d_in[2];
  p.w_in = (const float*)d_in[3]; p.g_nsa = (const float*)d_in[4]; p.g_dil = (const float*)d_in[5];
  p.pe = (const float*)d_in[6]; p.w1 = (const float*)d_in[7]; p.w2 = (const float*)d_in[8];
  p.w_out = (const float*)d_in[9]; p.w_up = (const float*)d_in[10]; p.w_down = (const float*)d_in[11];
  p.out = (float*)d_out; p.ws = (unsigned char*)d_ws;
  hipMemsetAsync((char*)d_ws + OFF_BAR, 0, 16384, stream);
  void* args[] = {&p};
  hipError_t e = hipLaunchCooperativeKernel((const void*)fwd_megakernel, dim3(grid_blocks), dim3(NTHR), args, LDS_BYTES, stream);
  if (e != hipSuccess) fprintf(stderr, "cooperative launch failed: %s (grid %d)\n", hipGetErrorString(e), grid_blocks);
}
```
